# Optimizing an MI355X kernel written in HIP

```python
import math
import jax, jax.numpy as jnp
from jax import lax
import numpy as np

D_MODEL = 1024
BATCH = 2
SEQ = 16384
DEPTH = 4

A_HEADS = 8
A_KV_HEADS = 2
A_HEAD_DIM = 64
A_WINDOW = 128
ROPE_THETA = 500000.0
A_ROPE_DIM = A_HEAD_DIM // 4
B_CHANNELS = D_MODEL // 2
B_CONV = 31
C_HEADS = 16
C_HEAD_DIM = 64
C_INNER = C_HEADS * C_HEAD_DIM
C_GROUPS = 2
C_STATE = 128
C_CONV = 4
C_CHUNK = 128
D_HEADS = 4
D_QK_DIM = 128
D_V_DIM = 256
D_CHUNK = 128
RET_THETA = 10000.0
FFN_HIDDEN = -(-(8 * D_MODEL) // (3 * 256)) * 256
ALPHA = (2 * DEPTH) ** 0.25
BETA = (8 * DEPTH) ** -0.25
NORM_EPS = 1e-5

N_EVEN = (DEPTH + 1) // 2
N_ODD = DEPTH // 2

EVEN_SPLITS = (A_HEADS * A_HEAD_DIM, A_KV_HEADS * A_HEAD_DIM, A_KV_HEADS * A_HEAD_DIM, 2 * B_CHANNELS)
EVEN_IN = sum(EVEN_SPLITS)
EVEN_MIX = A_HEADS * A_HEAD_DIM + B_CHANNELS
C_XBC = C_INNER + 2 * C_GROUPS * C_STATE
ODD_SPLITS = (C_INNER, C_XBC, C_HEADS, D_HEADS * D_QK_DIM, D_HEADS * D_QK_DIM, D_HEADS * D_V_DIM, D_HEADS * D_V_DIM)
ODD_IN = sum(ODD_SPLITS)
ODD_MIX = C_INNER + D_HEADS * D_V_DIM

kernel_name = "hybrid_swa_conformer_mamba2_retention_deepnorm"


def _split(t, sizes):
    idx = [int(v) for v in np.cumsum(sizes)[:-1]]
    return jnp.split(t, idx, axis=-1)


def layer_norm(x, g, b):
    xf = x.astype(jnp.float32)
    mu = jnp.mean(xf, axis=-1, keepdims=True)
    var = jnp.mean(jnp.square(xf - mu), axis=-1, keepdims=True)
    y = (xf - mu) * lax.rsqrt(var + NORM_EPS) * g.astype(jnp.float32) + b.astype(jnp.float32)
    return y.astype(x.dtype)


def causal_depthwise_conv(x, w, b):
    K, C = w.shape
    y = lax.conv_general_dilated(
        x, w[:, None, :].astype(x.dtype), window_strides=(1,), padding=[(K - 1, 0)],
        dimension_numbers=("NWC", "WIO", "NWC"), feature_group_count=C)
    return y + b.astype(x.dtype)


def apply_rotary(t, inv_freq):
    half = inv_freq.shape[0]
    S = t.shape[1]
    ang = jnp.arange(S, dtype=jnp.float32)[:, None] * inv_freq[None, :]
    cos = jnp.cos(ang)[None, :, None, :]
    sin = jnp.sin(ang)[None, :, None, :]
    tf = t.astype(jnp.float32)
    t1, t2, rest = tf[..., :half], tf[..., half:2 * half], tf[..., 2 * half:]
    out = jnp.concatenate([t1 * cos - t2 * sin, t2 * cos + t1 * sin, rest], axis=-1)
    return out.astype(t.dtype)


def swa_sink_attention(q, k, v, sinks):
    Bsz, S, Hq, Dh = q.shape
    Hkv = k.shape[2]
    G = Hq // Hkv
    W = A_WINDOW
    nb = S // W
    qb = q.reshape(Bsz, nb, W, Hkv, G, Dh)

    def with_prev(t):
        tb = t.reshape(Bsz, nb, W, Hkv, Dh)
        prev = jnp.pad(tb, ((0, 0), (1, 0), (0, 0), (0, 0), (0, 0)))[:, :-1]
        return jnp.concatenate([prev, tb], axis=2)

    kk, vv = with_prev(k), with_prev(v)
    s = jnp.einsum("bnqhgd,bnkhd->bnhgqk", qb, kk).astype(jnp.float32) * (Dh ** -0.5)
    i = jnp.arange(W)[:, None]
    j = jnp.arange(2 * W)[None, :]
    n = jnp.arange(nb)[:, None, None]
    valid = (j > i) & (j <= i + W) & (n * W + j >= W)
    s = jnp.where(valid[None, :, None, None], s, -jnp.inf)
    sink = sinks.astype(jnp.float32).reshape(Hkv, G)[None, None, :, :, None, None]
    m = jnp.maximum(jnp.max(s, axis=-1, keepdims=True), sink)
    p = jnp.exp(s - m)
    denom = jnp.sum(p, axis=-1, keepdims=True) + jnp.exp(sink - m)
    o = jnp.einsum("bnhgqk,bnkhd->bnqhgd", (p / denom).astype(v.dtype), vv)
    return o.reshape(Bsz, S, Hq * Dh)


def conformer_conv_branch(u, dw_w, dw_b, cn_g, cn_b):
    a, gate = jnp.split(u, 2, axis=-1)
    h = a * jax.nn.sigmoid(gate)
    h = causal_depthwise_conv(h, dw_w, dw_b)
    h = layer_norm(h, cn_g, cn_b)
    return jax.nn.silu(h)


def even_mixer(x, w_in, sinks, dw_w, dw_b, cn_g, cn_b, w_out):
    Bsz, S, _ = x.shape
    q, k, v, u = _split(x @ w_in, EVEN_SPLITS)
    half = A_ROPE_DIM // 2
    inv = jnp.power(jnp.float32(ROPE_THETA), -jnp.arange(half, dtype=jnp.float32) / half)
    q = apply_rotary(q.reshape(Bsz, S, A_HEADS, A_HEAD_DIM), inv)
    k = apply_rotary(k.reshape(Bsz, S, A_KV_HEADS, A_HEAD_DIM), inv)
    v = v.reshape(Bsz, S, A_KV_HEADS, A_HEAD_DIM)
    y_attn = swa_sink_attention(q, k, v, sinks).astype(x.dtype)
    y_conv = conformer_conv_branch(u, dw_w, dw_b, cn_g, cn_b).astype(x.dtype)
    return jnp.concatenate([y_attn, y_conv], axis=-1) @ w_out


def ssd_chunked(x, dt, a, bm, cm):
    Bsz, S, _ = x.shape
    L = C_CHUNK
    nc = S // L
    Hg = C_HEADS // C_GROUPS
    f32 = jnp.float32
    xh = x.astype(f32).reshape(Bsz, nc, L, C_GROUPS, Hg, C_HEAD_DIM)
    dtc = dt.reshape(Bsz, nc, L, C_GROUPS, Hg)
    bc = bm.astype(f32).reshape(Bsz, nc, L, C_GROUPS, C_STATE)
    cc = cm.astype(f32).reshape(Bsz, nc, L, C_GROUPS, C_STATE)
    acs = jnp.cumsum(dtc * a.reshape(C_GROUPS, Hg), axis=2)
    xdt = xh * dtc[..., None]
    seg = acs[:, :, :, None] - acs[:, :, None, :]
    causal = jnp.tril(jnp.ones((L, L), dtype=bool))
    decay = jnp.exp(jnp.where(causal[None, None, :, :, None, None], seg, -jnp.inf))
    cb = jnp.einsum("bclgn,bcsgn->bclsg", cc, bc)
    y_diag = jnp.einsum("bclsgh,bcsghp->bclghp", cb[..., None] * decay, xdt)
    to_end = jnp.exp(acs[:, :, -1:] - acs)
    states = jnp.einsum("bclgn,bclghp->bcghpn", bc, xdt * to_end[..., None])
    chunk_decay = jnp.exp(acs[:, :, -1])

    def step(carry, inp):
        st, dec = inp
        return carry * dec[..., None, None] + st, carry

    init = jnp.zeros((Bsz, C_GROUPS, Hg, C_HEAD_DIM, C_STATE), f32)
    _, prev = lax.scan(step, init, (jnp.moveaxis(states, 1, 0), jnp.moveaxis(chunk_decay, 1, 0)))
    prev = jnp.moveaxis(prev, 0, 1)
    y_off = jnp.einsum("bclgn,bcghpn->bclghp", cc, prev) * jnp.exp(acs)[..., None]
    return (y_diag + y_off).reshape(Bsz, S, C_INNER)


def mamba2_branch(z, xbc, dt, conv_w, conv_b, dt_bias, a_log, d_skip, norm_g):
    Bsz, S, _ = z.shape
    f32 = jnp.float32
    xbc = jax.nn.silu(causal_depthwise_conv(xbc, conv_w, conv_b))
    xs, bm, cm = _split(xbc, (C_INNER, C_GROUPS * C_STATE, C_GROUPS * C_STATE))
    dt = jax.nn.softplus(dt.astype(f32) + dt_bias.astype(f32))
    a = -jnp.exp(a_log.astype(f32))
    y = ssd_chunked(xs, dt, a, bm, cm)
    y = y + xs.astype(f32) * jnp.repeat(d_skip.astype(f32), C_HEAD_DIM)
    y = y * jax.nn.silu(z.astype(f32))
    yg = y.reshape(Bsz, S, C_GROUPS, C_INNER // C_GROUPS)
    yg = yg * lax.rsqrt(jnp.mean(yg * yg, axis=-1, keepdims=True) + NORM_EPS)
    return (yg.reshape(Bsz, S, C_INNER) * norm_g.astype(f32)).astype(z.dtype)


def retention_branch(q, k, v, g, gn_g, gn_b):
    Bsz, S, _ = q.shape
    f32 = jnp.float32
    L = D_CHUNK
    nc = S // L
    inv = 1.0 / jnp.power(jnp.float32(RET_THETA), jnp.linspace(0.0, 1.0, D_QK_DIM // 2, dtype=f32))
    q = apply_rotary(q.reshape(Bsz, S, D_HEADS, D_QK_DIM), inv)
    k = apply_rotary(k.reshape(Bsz, S, D_HEADS, D_QK_DIM), inv)
    qc = q.astype(f32).reshape(Bsz, nc, L, D_HEADS, D_QK_DIM)
    kc = k.astype(f32).reshape(Bsz, nc, L, D_HEADS, D_QK_DIM) * (D_QK_DIM ** -0.5)
    vc = v.astype(f32).reshape(Bsz, nc, L, D_HEADS, D_V_DIM)
    log_gamma = jnp.log(1.0 - jnp.power(2.0, -5.0 - jnp.arange(D_HEADS, dtype=f32)))
    idx = jnp.arange(L, dtype=f32)
    rel = idx[:, None] - idx[None, :]
    dmat = jnp.where(rel[None] >= 0, jnp.exp(log_gamma[:, None, None] * jnp.maximum(rel, 0.0)[None]), 0.0)
    scores = jnp.einsum("bclhd,bcshd->bchls", qc, kc) * dmat
    y = jnp.einsum("bchls,bcshv->bclhv", scores, vc)
    to_end = jnp.exp(log_gamma[None, :] * (L - 1 - idx)[:, None])
    kv = jnp.einsum("bclhd,bclhv->bchdv", kc * to_end[..., None], vc)
    chunk_decay = jnp.exp(log_gamma * L)

    def step(r, kv_c):
        return r * chunk_decay[:, None, None] + kv_c, r

    init = jnp.zeros((Bsz, D_HEADS, D_QK_DIM, D_V_DIM), f32)
    _, prev = lax.scan(step, init, jnp.moveaxis(kv, 1, 0))
    prev = jnp.moveaxis(prev, 0, 1)
    from_start = jnp.exp(log_gamma[None, :] * (idx + 1.0)[:, None])
    y = y + jnp.einsum("bclhd,bchdv->bclhv", qc, prev) * from_start[..., None]
    y = y.reshape(Bsz, S, D_HEADS, D_V_DIM)
    mu = jnp.mean(y, axis=-1, keepdims=True)
    var = jnp.mean(jnp.square(y - mu), axis=-1, keepdims=True)
    y = ((y - mu) * lax.rsqrt(var + NORM_EPS)).reshape(Bsz, S, D_HEADS * D_V_DIM)
    y = y * gn_g.astype(f32) + gn_b.astype(f32)
    return (jax.nn.silu(g.astype(f32)) * y).astype(g.dtype)


def odd_mixer(x, w_in, conv_w, conv_b, dt_bias, a_log, d_skip, ssm_norm_g, ret_gn_g, ret_gn_b, w_out):
    z, xbc, dt, rq, rk, rv, rg = _split(x @ w_in, ODD_SPLITS)
    y_ssm = mamba2_branch(z, xbc, dt, conv_w, conv_b, dt_bias, a_log, d_skip, ssm_norm_g)
    y_ret = retention_branch(rq, rk, rv, rg, ret_gn_g, ret_gn_b)
    return jnp.concatenate([y_ssm, y_ret], axis=-1) @ w_out


def swiglu(x, w_gate, w_up, w_down):
    return (jax.nn.silu(x @ w_gate) * (x @ w_up)) @ w_down


def setup_inputs(seed: int = 0) -> dict:
    key = jax.random.key(seed)
    ks = jax.random.split(key, 25)
    f32 = jnp.float32

    def nrm(k, shape, scale):
        return scale * jax.random.normal(k, shape, f32)

    dt0 = jnp.exp(jax.random.uniform(ks[18], (N_ODD, C_HEADS), f32, math.log(1e-3), math.log(1e-1)))
    return {
        "x": jax.random.normal(ks[0], (BATCH, SEQ, D_MODEL), f32),
        "ln_mix_g": 1.0 + nrm(ks[1], (DEPTH, D_MODEL), 0.02),
        "ln_mix_b": nrm(ks[2], (DEPTH, D_MODEL), 0.02),
        "ln_ffn_g": 1.0 + nrm(ks[3], (DEPTH, D_MODEL), 0.02),
        "ln_ffn_b": nrm(ks[4], (DEPTH, D_MODEL), 0.02),
        "ffn_w_gate": nrm(ks[5], (DEPTH, D_MODEL, FFN_HIDDEN), D_MODEL ** -0.5),
        "ffn_w_up": nrm(ks[6], (DEPTH, D_MODEL, FFN_HIDDEN), D_MODEL ** -0.5),
        "ffn_w_down": nrm(ks[7], (DEPTH, FFN_HIDDEN, D_MODEL), BETA * FFN_HIDDEN ** -0.5),
        "ev_w_in": nrm(ks[8], (N_EVEN, D_MODEL, EVEN_IN), D_MODEL ** -0.5),
        "ev_sinks": nrm(ks[9], (N_EVEN, A_HEADS), 0.5),
        "ev_dw_w": nrm(ks[10], (N_EVEN, B_CONV, B_CHANNELS), B_CONV ** -0.5),
        "ev_dw_b": nrm(ks[11], (N_EVEN, B_CHANNELS), 0.02),
        "ev_cn_g": 1.0 + nrm(ks[12], (N_EVEN, B_CHANNELS), 0.02),
        "ev_cn_b": nrm(ks[13], (N_EVEN, B_CHANNELS), 0.02),
        "ev_w_out": nrm(ks[14], (N_EVEN, EVEN_MIX, D_MODEL), BETA * EVEN_MIX ** -0.5),
        "od_w_in": nrm(ks[15], (N_ODD, D_MODEL, ODD_IN), D_MODEL ** -0.5),
        "od_conv_w": nrm(ks[16], (N_ODD, C_CONV, C_XBC), C_CONV ** -0.5),
        "od_conv_b": nrm(ks[17], (N_ODD, C_XBC), 0.02),
        "od_dt_bias": dt0 + jnp.log(-jnp.expm1(-dt0)),
        "od_a_log": jnp.log(jax.random.uniform(ks[19], (N_ODD, C_HEADS), f32, 1.0, 16.0)),
        "od_d_skip": 1.0 + nrm(ks[20], (N_ODD, C_HEADS), 0.1),
        "od_ssm_norm_g": 1.0 + nrm(ks[21], (N_ODD, C_INNER), 0.02),
        "od_ret_gn_g": 1.0 + nrm(ks[22], (N_ODD, D_HEADS * D_V_DIM), 0.02),
        "od_ret_gn_b": nrm(ks[23], (N_ODD, D_HEADS * D_V_DIM), 0.02),
        "od_w_out": nrm(ks[24], (N_ODD, ODD_MIX, D_MODEL), BETA * ODD_MIX ** -0.5),
    }


def reference(x, ln_mix_g, ln_mix_b, ln_ffn_g, ln_ffn_b, ffn_w_gate, ffn_w_up, ffn_w_down,
              ev_w_in, ev_sinks, ev_dw_w, ev_dw_b, ev_cn_g, ev_cn_b, ev_w_out,
              od_w_in, od_conv_w, od_conv_b, od_dt_bias, od_a_log, od_d_skip, od_ssm_norm_g,
              od_ret_gn_g, od_ret_gn_b, od_w_out):
    for layer in range(DEPTH):
        if layer % 2 == 0:
            e = layer // 2
            h = even_mixer(x, ev_w_in[e], ev_sinks[e], ev_dw_w[e], ev_dw_b[e],
                           ev_cn_g[e], ev_cn_b[e], ev_w_out[e])
        else:
            o = layer // 2
            h = odd_mixer(x, od_w_in[o], od_conv_w[o], od_conv_b[o], od_dt_bias[o], od_a_log[o],
                          od_d_skip[o], od_ssm_norm_g[o], od_ret_gn_g[o], od_ret_gn_b[o], od_w_out[o])
        x = layer_norm(ALPHA * x + h.astype(x.dtype), ln_mix_g[layer], ln_mix_b[layer])
        f = swiglu(x, ffn_w_gate[layer], ffn_w_up[layer], ffn_w_down[layer])
        x = layer_norm(ALPHA * x + f.astype(x.dtype), ln_ffn_g[layer], ln_ffn_b[layer])
    return x
```

```cpp
#include <hip/hip_runtime.h>
#include <hip/hip_cooperative_groups.h>
#include <cstdio>
#include <cstdint>
#include <cmath>
namespace pg8 {
#define PG8_LAS __attribute__((address_space(3)))
typedef unsigned short bf16_t;
typedef short bf16x8 __attribute__((ext_vector_type(8)));
typedef float f32x4 __attribute__((ext_vector_type(4)));
typedef unsigned u32x4 __attribute__((ext_vector_type(4)));
constexpr int BM = 256, BK = 64, HALF = 128, HTB = HALF * BK * 2  , STAGE_BYTES = 8 * HTB, NXCD = 8, WGM = 8;

__host__ __device__ __forceinline__ int lds_byte(int r, int c) { const int st = (r >> 4) * 2 + (c >> 5), rr = r & 15, cc = c & 31, ob = rr * 64 + cc * 2; return st * 1024 + (ob ^ (((ob >> 9) & 1) << 5)); }
__host__ __device__ __forceinline__ void stage_rc(int b, int& R, int& C) { const int st = b / 1024, sb = b % 1024, swz = sb ^ (((sb >> 9) & 1) << 5); R = (st >> 1) * 16 + swz / 64; C = (st & 1) * 32 + (swz % 64) / 2; }
__host__ __device__ __forceinline__ int perm32(int rho) { const int n = rho >> 4, i = rho & 15; return 8 * (i >> 2) + 4 * n + (i & 3); }

struct Unit { int pm, pn; };
struct Gemm { const bf16_t* A; const bf16_t* Bt; int M, N, K; };

struct StaticOrder {
    int nM, nN, nwg, G, c;
    __host__ __device__ void init(int M, int N, int G_, int c_) { nM = M / BM; nN = N / BM; nwg = nM * nN; G = G_; c = c_; }
    __host__ __device__ bool next(int i, Unit& u) const {
        const long L = (long)i * G + c; if (L >= nwg) return false;
        int wgid = (int)L; { const int q = nwg / NXCD, r = nwg % NXCD, xcd = wgid % NXCD, off = wgid / NXCD; wgid = (xcd < r ? xcd * (q + 1) : r * (q + 1) + (xcd - r) * q) + off; }
        const int nig = WGM * nN, gid = wgid / nig, fm = gid * WGM, gsz = (nM - fm) < WGM ? (nM - fm) : WGM;
        u.pm = fm + ((wgid % nig) % gsz); u.pn = (wgid % nig) / gsz; return true;
    }
    __device__ __forceinline__ void a_ready(const Unit&) const {}
    __device__ __forceinline__ void done(const Unit&) const {}
};

__device__ __forceinline__ unsigned cvt_pk_bf16(float lo, float hi) { unsigned r; asm volatile("v_cvt_pk_bf16_f32 %0, %1, %2" : "=v"(r) : "v"(lo), "v"(hi)); return r; }
typedef float f32x2 __attribute__((ext_vector_type(2)));
__device__ __forceinline__ f32x2 gelu_pk(f32x2 v) {
    const f32x2 av = __builtin_elementwise_abs(v), d = av * 0.2316418882f + 1.0f;
    f32x2 t; t.x = __builtin_amdgcn_rcpf(d.x); t.y = __builtin_amdgcn_rcpf(d.y);
    f32x2 q = t * 0.5307027145f + (-0.7265760135f); q = q * t + 0.7107068705f; q = q * t + (-0.142248368f); q = q * t + 0.127414796f; q = q * t;
    const f32x2 s = (v * v) * (-0.72134752044f);
    f32x2 e; e.x = __builtin_amdgcn_exp2f(s.x); e.y = __builtin_amdgcn_exp2f(s.y);
    const f32x2 m = v * (q * e), r = v - m;
    f32x2 o; o.x = v.x < 0.f ? m.x : r.x; o.y = v.y < 0.f ? m.y : r.y; return o;
}

template <int ACT  > struct EpiBf16 {
    static constexpr bool PERM = true, AFTER_DRAIN = false; static_assert(ACT == 0 || ACT == 1, "EpiBf16: ACT is 0 (none) or 1 (gelu_pk)");
    bf16_t* O; int ldc; const float* bias; int split_cols; size_t split_stride; float scale0;
    __device__ __forceinline__ void operator()(const f32x4 (&acc)[2][2][4][2], const Unit& u, int wr, int wc, int fr, int fq) const {
        const int row0 = u.pm * BM + wr * 64 + fr; int colt = u.pn * BM; bf16_t* base = O;
        float sc = 1.f; if (split_cols) { const int t = colt / split_cols; base += (size_t)t * split_stride; colt -= t * split_cols; if (t == 0) sc = scale0; }
        const int col0 = colt + wc * 32 + 8 * fq, bcol0 = u.pn * BM + wc * 32 + 8 * fq;
        f32x4 bv[2][2];
#pragma unroll
        for (int bj = 0; bj < 2; ++bj)
#pragma unroll
            for (int n = 0; n < 2; ++n) bv[bj][n] = bias ? *(const f32x4*)(bias + bcol0 + bj * HALF + 4 * n) : (f32x4){0.f, 0.f, 0.f, 0.f};
#pragma unroll
        for (int ai = 0; ai < 2; ++ai)
#pragma unroll
            for (int m = 0; m < 4; ++m) { bf16_t* rowp = base + (size_t)(row0 + ai * HALF + m * 16) * ldc + col0;
#pragma unroll
                for (int bj = 0; bj < 2; ++bj) { f32x4 v0 = acc[ai][bj][m][0] + bv[bj][0], v1 = acc[ai][bj][m][1] + bv[bj][1];
                    if (ACT == 1) { f32x2 a = gelu_pk((f32x2){v0[0], v0[1]}), b = gelu_pk((f32x2){v0[2], v0[3]}), c = gelu_pk((f32x2){v1[0], v1[1]}), d = gelu_pk((f32x2){v1[2], v1[3]});
                        v0 = (f32x4){a.x, a.y, b.x, b.y}; v1 = (f32x4){c.x, c.y, d.x, d.y}; }
                    v0 = v0 * sc; v1 = v1 * sc; u32x4 w; w.x = cvt_pk_bf16(v0[0], v0[1]); w.y = cvt_pk_bf16(v0[2], v0[3]); w.z = cvt_pk_bf16(v1[0], v1[1]); w.w = cvt_pk_bf16(v1[2], v1[3]);
                    *(u32x4*)(rowp + bj * HALF) = w; } }
    }
};
__device__ __forceinline__ float silu_f(float x) { return x / (1.0f + __expf(-x)); }
struct EpiSwiglu {
    static constexpr bool PERM = true, AFTER_DRAIN = false;
    bf16_t* O; int ldc;
    __device__ __forceinline__ void operator()(const f32x4 (&acc)[2][2][4][2], const Unit& u, int wr, int wc, int fr, int fq) const {
        const int row0 = u.pm * BM + wr * 64 + fr; const int col0 = u.pn * HALF + wc * 32 + 8 * fq;
#pragma unroll
        for (int ai = 0; ai < 2; ++ai)
#pragma unroll
            for (int m = 0; m < 4; ++m) { bf16_t* rowp = O + (size_t)(row0 + ai * HALF + m * 16) * ldc + col0;
                const f32x4 g0 = acc[ai][0][m][0], g1 = acc[ai][0][m][1], u0 = acc[ai][1][m][0], u1 = acc[ai][1][m][1];
                u32x4 w;
                w.x = cvt_pk_bf16(silu_f(g0[0]) * u0[0], silu_f(g0[1]) * u0[1]); w.y = cvt_pk_bf16(silu_f(g0[2]) * u0[2], silu_f(g0[3]) * u0[3]);
                w.z = cvt_pk_bf16(silu_f(g1[0]) * u1[0], silu_f(g1[1]) * u1[1]); w.w = cvt_pk_bf16(silu_f(g1[2]) * u1[2], silu_f(g1[3]) * u1[3]);
                *(u32x4*)rowp = w; }
    }
};
struct EpiRes {
    static constexpr bool PERM = false, AFTER_DRAIN = false;
    const float* res; float* out; int ldc; float alpha;
    __device__ __forceinline__ void operator()(const f32x4 (&acc)[2][2][4][2], const Unit& u, int wr, int wc, int fr, int fq) const {
        const int row0 = u.pm * BM + wr * 64 + fr, col0 = u.pn * BM + wc * 32 + 4 * fq;
#pragma unroll
        for (int ai = 0; ai < 2; ++ai)
#pragma unroll
            for (int m = 0; m < 4; ++m) { const size_t off = (size_t)(row0 + ai * HALF + m * 16) * ldc + col0;
#pragma unroll
                for (int bj = 0; bj < 2; ++bj)
#pragma unroll
                    for (int n = 0; n < 2; ++n) { const f32x4 x = *(const f32x4*)(res + off + bj * HALF + n * 16);
                        *(f32x4*)(out + off + bj * HALF + n * 16) = x * alpha + acc[ai][bj][m][n]; } }
    }
};
template <class Epi, class Sched, bool ALIGN_EPI = false, bool SP2 = false>
__device__ __forceinline__ void gemm_phase(PG8_LAS unsigned char* lds, const Gemm g, const Sched& S, const Epi& E) {
    int tid_l = threadIdx.x; asm volatile("" : "+v"(tid_l)); const int tid = tid_l, wid = __builtin_amdgcn_readfirstlane(tid >> 6), lane = tid & 63, wr = wid >> 2, wc = wid & 3, fr = lane & 15, fq = lane >> 4;
    const int K = g.K, nt = K / BK;
    unsigned voffA[2], voffB[2];
#pragma unroll
    for (int i = 0; i < 2; ++i) { int R, C; stage_rc(tid * 16 + i * 8192, R, C); const int Rb = Epi::PERM ? ((R & ~31) + perm32(R & 31)) : R;
        voffA[i] = (unsigned)(R * K + C) * 2u; voffB[i] = (unsigned)(Rb * K + C) * 2u; }
    const size_t kstep = (size_t)(BK * 2);
    const size_t hstep = (size_t)HALF * K * 2;
    const size_t tstep = 2 * hstep;
    const unsigned ldsw = (unsigned)wid * 1024u;
    const int aoff = lds_byte(wr * 64 + fr, fq * 8), boff = lds_byte(wc * 32 + fr, fq * 8);
#define PG8_SA(b, h) (((b) * 2 + (h)) * HTB)
#define PG8_SB(b, h) ((4 + (b) * 2 + (h)) * HTB)
#define PG8_STAGE(bufoff, gbase, voff) do { _Pragma("unroll") for (int _i = 0; _i < 2; ++_i) \
        __builtin_amdgcn_global_load_lds((const unsigned*)((const char*)(gbase) + (voff)[_i]), (PG8_LAS unsigned*)(lds + (bufoff) + ldsw + _i * 8192), 16, 0, 0); } while (0)
#define PG8_LDA(dst, b, h) do { _Pragma("unroll") for (int m = 0; m < 4; ++m) _Pragma("unroll") for (int k = 0; k < 2; ++k) dst[m][k] = *(const PG8_LAS bf16x8*)(lds + PG8_SA(b, h) + aoff + m * 2048 + k * 1024); } while (0)
#define PG8_LDB(dst, b, h) do { _Pragma("unroll") for (int n = 0; n < 2; ++n) _Pragma("unroll") for (int k = 0; k < 2; ++k) dst[n][k] = *(const PG8_LAS bf16x8*)(lds + PG8_SB(b, h) + boff + n * 2048 + k * 1024); } while (0)
#define PG8_MMA(ai, bj, At, Bt) do { __builtin_amdgcn_s_setprio(1); _Pragma("unroll") for (int m = 0; m < 4; ++m) _Pragma("unroll") for (int n = 0; n < 2; ++n) _Pragma("unroll") for (int k = 0; k < 2; ++k) \
        acc[ai][bj][m][n] = __builtin_amdgcn_mfma_f32_16x16x32_bf16(Bt[n][k], At[m][k], acc[ai][bj][m][n], 0, 0, 0); __builtin_amdgcn_s_setprio(0); } while (0)
#define PG8_WAIT_V(n) asm volatile("s_waitcnt vmcnt(" #n ")" ::: "memory")
#define PG8_WAIT_L(n) asm volatile("s_waitcnt lgkmcnt(" #n ")" ::: "memory")
#define PG8_BAR __builtin_amdgcn_s_barrier()
#define PG8_SCHED __builtin_amdgcn_sched_barrier(0)
    Unit cur, nxt; int ui = 0;
    if (!S.next(0, cur)) return;
    f32x4 acc[2][2][4][2];
#pragma unroll
    for (int a = 0; a < 2; ++a)
#pragma unroll
        for (int b = 0; b < 2; ++b)
#pragma unroll
            for (int m = 0; m < 4; ++m)
#pragma unroll
                for (int n = 0; n < 2; ++n) acc[a][b][m][n] = (f32x4){0.f, 0.f, 0.f, 0.f};
    bf16x8 At[4][2], B0[2][2], B1[2][2];
    const char* cA = (const char*)g.A + (size_t)cur.pm * tstep; const char* cB = (const char*)g.Bt + (size_t)cur.pn * tstep;
    S.a_ready(cur);
    if constexpr (SP2) {
        PG8_STAGE(PG8_SB(0, 0), cB, voffB); PG8_STAGE(PG8_SB(0, 1), cB + hstep, voffB); PG8_STAGE(PG8_SA(0, 0), cA, voffA); PG8_STAGE(PG8_SA(0, 1), cA + hstep, voffA);
        if (wr == 1) PG8_BAR;
        PG8_WAIT_V(2); PG8_BAR;
        PG8_STAGE(PG8_SB(1, 0), cB + kstep, voffB); PG8_STAGE(PG8_SA(1, 0), cA + kstep, voffA); PG8_STAGE(PG8_SB(1, 1), cB + hstep + kstep, voffB);
        PG8_WAIT_V(6); PG8_BAR;
    } else {
        PG8_STAGE(PG8_SB(0, 0), cB, voffB); PG8_STAGE(PG8_SA(0, 0), cA, voffA); PG8_STAGE(PG8_SB(0, 1), cB + hstep, voffB); PG8_STAGE(PG8_SA(0, 1), cA + hstep, voffA);
        if (wr == 1) PG8_BAR;
        PG8_WAIT_V(4); PG8_BAR;
        PG8_STAGE(PG8_SB(1, 0), cB + kstep, voffB); PG8_STAGE(PG8_SA(1, 0), cA + kstep, voffA); PG8_STAGE(PG8_SB(1, 1), cB + hstep + kstep, voffB);
        PG8_WAIT_V(6); PG8_BAR;
    }
    for (;;) {
        const bool has_next = S.next(ui + 1, nxt);
        const char* nA = has_next ? (const char*)g.A + (size_t)nxt.pm * tstep : cA; const char* nB = has_next ? (const char*)g.Bt + (size_t)nxt.pn * tstep : cB;
        for (int t = 0; t < nt; t += 2) {
            const bool last = (t == nt - 2);
            const char* a1 = cA + (size_t)(t + 1) * kstep;
            const char* a2 = last ? nA : cA + (size_t)(t + 2) * kstep; const char* b2 = last ? nB : cB + (size_t)(t + 2) * kstep;
            const char* a3 = a2 + kstep; const char* b3 = b2 + kstep;
            if (last && has_next) S.a_ready(nxt);
            if constexpr (SP2) {
            PG8_LDB(B0, 0, 0); PG8_LDB(B1, 0, 1); PG8_SCHED; PG8_LDA(At, 0, 0); PG8_STAGE(PG8_SA(1, 1), a1 + hstep, voffA);
            PG8_WAIT_V(8); PG8_WAIT_L(0); PG8_BAR; PG8_MMA(0, 0, At, B0); PG8_MMA(0, 1, At, B1); PG8_BAR; PG8_SCHED;
            PG8_LDA(At, 0, 1); PG8_STAGE(PG8_SB(0, 0), b2, voffB); PG8_STAGE(PG8_SB(0, 1), b2 + hstep, voffB); PG8_STAGE(PG8_SA(0, 0), a2, voffA);
            PG8_WAIT_V(8); PG8_WAIT_L(0); PG8_BAR; PG8_MMA(1, 0, At, B0); PG8_MMA(1, 1, At, B1); PG8_BAR; PG8_SCHED;
            PG8_LDB(B0, 1, 0); PG8_LDB(B1, 1, 1); PG8_SCHED; PG8_LDA(At, 1, 0); PG8_STAGE(PG8_SA(0, 1), a2 + hstep, voffA);
            PG8_WAIT_V(8); PG8_WAIT_L(0); PG8_BAR; PG8_MMA(0, 0, At, B0); PG8_MMA(0, 1, At, B1); PG8_BAR; PG8_SCHED;
            PG8_LDA(At, 1, 1); PG8_STAGE(PG8_SB(1, 0), b3, voffB); PG8_STAGE(PG8_SB(1, 1), b3 + hstep, voffB); PG8_STAGE(PG8_SA(1, 0), a3, voffA);
            PG8_WAIT_V(8); PG8_WAIT_L(0); PG8_BAR; PG8_MMA(1, 0, At, B0); PG8_MMA(1, 1, At, B1); PG8_BAR; PG8_SCHED;
            } else {
            PG8_LDB(B0, 0, 0); PG8_SCHED; PG8_LDA(At, 0, 0); PG8_STAGE(PG8_SA(1, 1), a1 + hstep, voffA);
            PG8_WAIT_L(8); PG8_BAR; PG8_WAIT_L(0); PG8_MMA(0, 0, At, B0); PG8_BAR; PG8_SCHED;
            PG8_LDB(B1, 0, 1); PG8_STAGE(PG8_SB(0, 0), b2, voffB);
            PG8_BAR; PG8_WAIT_L(0); PG8_MMA(0, 1, At, B1); PG8_BAR;
            PG8_LDA(At, 0, 1); PG8_STAGE(PG8_SA(0, 0), a2, voffA);
            PG8_BAR; PG8_WAIT_L(0); PG8_MMA(1, 0, At, B0); PG8_BAR; PG8_SCHED;
            PG8_STAGE(PG8_SB(0, 1), b2 + hstep, voffB);
            PG8_WAIT_V(6); PG8_BAR; PG8_MMA(1, 1, At, B1); PG8_BAR;
            PG8_LDB(B0, 1, 0); PG8_SCHED; PG8_LDA(At, 1, 0); PG8_STAGE(PG8_SA(0, 1), a2 + hstep, voffA);
            PG8_WAIT_L(8); PG8_BAR; PG8_WAIT_L(0); PG8_MMA(0, 0, At, B0); PG8_BAR; PG8_SCHED;
            PG8_LDB(B1, 1, 1); PG8_STAGE(PG8_SB(1, 0), b3, voffB);
            PG8_BAR; PG8_WAIT_L(0); PG8_MMA(0, 1, At, B1); PG8_BAR;
            PG8_LDA(At, 1, 1); PG8_STAGE(PG8_SA(1, 0), a3, voffA);
            PG8_BAR; PG8_WAIT_L(0); PG8_MMA(1, 0, At, B0); PG8_BAR; PG8_SCHED;
            PG8_STAGE(PG8_SB(1, 1), b3 + hstep, voffB);
            PG8_WAIT_V(6); PG8_BAR; PG8_MMA(1, 1, At, B1); PG8_BAR;
            }
        }
        if constexpr (ALIGN_EPI) { if (wr == 0) PG8_BAR; }
        if constexpr (!Epi::AFTER_DRAIN) { E(acc, cur, wr, wc, fr, fq); S.done(cur); }
        if (!has_next) break;
#pragma unroll
        for (int a = 0; a < 2; ++a)
#pragma unroll
            for (int b = 0; b < 2; ++b)
#pragma unroll
                for (int m = 0; m < 4; ++m)
#pragma unroll
                    for (int n = 0; n < 2; ++n) acc[a][b][m][n] = (f32x4){0.f, 0.f, 0.f, 0.f};
        cur = nxt; cA = nA; cB = nB; ++ui;
        if constexpr (ALIGN_EPI) { if (wr == 1) PG8_BAR; }
    }
    PG8_WAIT_V(0);
    if constexpr (!ALIGN_EPI) { if (wr == 0) PG8_BAR; }
    PG8_BAR;
    if constexpr (Epi::AFTER_DRAIN) { E.fused(acc, cur, wr, wc, fr, fq, lds, wid, lane); S.done(cur); }
#undef PG8_SA
#undef PG8_SB
#undef PG8_STAGE
#undef PG8_LDA
#undef PG8_LDB
#undef PG8_MMA
#undef PG8_WAIT_V
#undef PG8_WAIT_L
#undef PG8_BAR
#undef PG8_SCHED
}
}

namespace cg = cooperative_groups;
namespace mk {
using pg8::bf16_t; using pg8::bf16x8; using pg8::f32x4; using pg8::u32x4;
typedef unsigned u32x2 __attribute__((ext_vector_type(2)));
typedef short bf16x4 __attribute__((ext_vector_type(4)));
#define LAS __attribute__((address_space(3)))

constexpr int BATCH = 2, SEQ = 16384, DM = 1024, M = BATCH * SEQ, FFH = 2816;
constexpr float ALPHA = 1.681792830507429f, EPS = 1e-5f, LOG2E = 1.4426950408889634f;
constexpr size_t MiB = 1u << 20;
constexpr size_t WS_W = 1 * MiB, WS_XN = 33 * MiB, WS_PROJ = 97 * MiB, WS_MIX = 289 * MiB, WS_ST = 417 * MiB, WS_DEC = 481 * MiB, WS_TAB = 481 * MiB + 65536;
constexpr size_t WO_IN = 0, WO_OUT = (size_t)5888 * 1024, WO_GU = WO_OUT + (size_t)1024 * 2048, WO_D = WO_GU + (size_t)5632 * 1024;
constexpr int LDS_BYTES = 147456;

__device__ __forceinline__ float bflo(unsigned w) { return __uint_as_float(w << 16); }
__device__ __forceinline__ float bfhi(unsigned w) { return __uint_as_float(w & 0xffff0000u); }
__device__ __forceinline__ float bf2f(bf16_t v) { return __uint_as_float(((unsigned)v) << 16); }
__device__ __forceinline__ unsigned f2bf(float f) { unsigned u = __float_as_uint(f); return (u + 0x7fffu + ((u >> 16) & 1u)) >> 16; }
__device__ __forceinline__ unsigned pk2(float lo, float hi) { return f2bf(lo) | (f2bf(hi) << 16); }
__device__ __forceinline__ void unpack8(const u32x4 v, float* o) { o[0] = bflo(v.x); o[1] = bfhi(v.x); o[2] = bflo(v.y); o[3] = bfhi(v.y); o[4] = bflo(v.z); o[5] = bfhi(v.z); o[6] = bflo(v.w); o[7] = bfhi(v.w); }
__device__ __forceinline__ u32x4 pack8(const float* o) { u32x4 v; v.x = pk2(o[0], o[1]); v.y = pk2(o[2], o[3]); v.z = pk2(o[4], o[5]); v.w = pk2(o[6], o[7]); return v; }
__device__ __forceinline__ float silu(float x) { return x / (1.0f + __expf(-x)); }
__device__ __forceinline__ float wave_sum(float v) {
#pragma unroll
    for (int o = 1; o < 64; o <<= 1) v += __shfl_xor(v, o);
    return v;
}
__device__ __forceinline__ f32x4 mfma16(bf16x8 a, bf16x8 b, f32x4 c) { return __builtin_amdgcn_mfma_f32_16x16x32_bf16(a, b, c, 0, 0, 0); }
__device__ __forceinline__ bf16x8 cat44(bf16x4 a, bf16x4 b) { return __builtin_shufflevector(a, b, 0, 1, 2, 3, 4, 5, 6, 7); }
__device__ __forceinline__ bf16x8 packf8(f32x4 a, f32x4 b) { u32x4 v; v.x = pk2(a[0], a[1]); v.y = pk2(a[2], a[3]); v.z = pk2(b[0], b[1]); v.w = pk2(b[2], b[3]); return __builtin_bit_cast(bf16x8, v); }
__device__ __forceinline__ void sincos_ang(float ang, float& s, float& c) {
    double t = (double)ang * 0.15915494309189535; t -= rint(t); const float f = (float)t;
    s = __builtin_amdgcn_sinf(f); c = __builtin_amdgcn_cosf(f);
}
__device__ __forceinline__ float log2gamma(int h) { return h == 0 ? -0.04580368961312479f : h == 1 ? -0.02272007650008353f : h == 2 ? -0.011315313227834146f : -0.005646563141142063f; }
__device__ __forceinline__ float softplus(float x) { return x > 20.f ? x : log1pf(__expf(x)); }

#define LAUNDER_V(x) asm volatile("" : "+v"(x))
#define LAUNDER_S(x) asm volatile("" : "+s"(x))
struct Params { const float* in[25]; float* out; unsigned char* ws; };
constexpr int PTR_OFF = LDS_BYTES - 256;
__device__ __forceinline__ unsigned long long ldq(LAS unsigned char* lds, int i) {
    volatile LAS unsigned long long* t = (volatile LAS unsigned long long*)(lds + PTR_OFF); const unsigned long long v = t[i];
    const unsigned lo = __builtin_amdgcn_readfirstlane((unsigned)v), hi = __builtin_amdgcn_readfirstlane((unsigned)(v >> 32));
    return ((unsigned long long)hi << 32) | lo;
}
__device__ __forceinline__ const float* ldin(LAS unsigned char* lds, int i) { return (const float*)ldq(lds, i); }
__device__ __forceinline__ unsigned char* ldws(LAS unsigned char* lds) { return (unsigned char*)ldq(lds, 26); }
__device__ __forceinline__ float* ldout(LAS unsigned char* lds) { return (float*)ldq(lds, 25); }


__device__ __forceinline__ void tr_item(const float* W, int N, int k0, int nsrc0, bf16_t* WT, int K, int drow0, LAS float* scr, int lane) {
#pragma unroll 8
    for (int i = 0; i < 32; ++i) { const int kk = 2 * i + (lane >> 5); scr[kk * 33 + (lane & 31)] = W[(size_t)(k0 + kk) * N + nsrc0 + (lane & 31)]; }
    asm volatile("s_waitcnt lgkmcnt(0)" ::: "memory");
    const int c = lane & 7;
#pragma unroll
    for (int j = 0; j < 4; ++j) { const int n = (lane >> 3) + 8 * j; const LAS float* s = scr + (8 * c) * 33 + n;
        u32x4 o; o.x = pk2(s[0 * 33], s[1 * 33]); o.y = pk2(s[2 * 33], s[3 * 33]); o.z = pk2(s[4 * 33], s[5 * 33]); o.w = pk2(s[6 * 33], s[7 * 33]);
        *(u32x4*)(WT + (size_t)(drow0 + n) * K + k0 + 8 * c) = o; }
    asm volatile("s_waitcnt lgkmcnt(0)" ::: "memory");
}
__device__ __forceinline__ void convert_layer(int L, LAS unsigned char* lds, int gw, int NGW, int lane, int wave, int gtid, int nthr) {
    LAUNDER_V(lane); LAUNDER_S(wave); LAUNDER_S(gw); LAUNDER_V(gtid);
    bf16_t* Wb = (bf16_t*)(ldws(lds) + WS_W);
    LAS float* scr = (LAS float*)(lds + wave * 16384);
    const int e = L >> 1; const bool odd = (L & 1) != 0;
    const int cIN = odd ? (16 * 80 + 16 * 96) : 16 * 56, cOUT = odd ? 32 * 32 : 16 * 32, cG = 16 * 88, cD = 44 * 32;
    const int total = cIN + cOUT + 2 * cG + cD;
    for (int it = gw; it < total; it += NGW) {
        int r = it; const float* W; int N, k0, nsrc0, K, drow0; bf16_t* WT;
        if (r < cIN) {
            WT = Wb + WO_IN; K = 1024;
            if (!odd) { const int nb = r % 56, kb = r / 56; W = ldin(lds, 8) + (size_t)e * 1024 * 1792; N = 1792; k0 = kb * 64; nsrc0 = nb * 32; drow0 = nb * 32; }
            else if (r < 1280) { const int nb = r % 80, kb = r / 80; W = ldin(lds, 15) + (size_t)e * 1024 * 5648; N = 5648; k0 = kb * 64; nsrc0 = nb * 32; drow0 = nb * 32; }
            else { const int r2 = r - 1280; const int nb = r2 % 96, kb = r2 / 96; W = ldin(lds, 15) + (size_t)e * 1024 * 5648; N = 5648; k0 = kb * 64; nsrc0 = 2576 + nb * 32; drow0 = 2816 + nb * 32; }
        } else if ((r -= cIN) < cOUT) {
            WT = Wb + WO_OUT; const int nb = r % 32, kb = r / 32; N = 1024; k0 = kb * 64; nsrc0 = nb * 32; drow0 = nb * 32;
            if (!odd) { W = ldin(lds, 14) + (size_t)e * 1024 * 1024; K = 1024; } else { W = ldin(lds, 24) + (size_t)e * 2048 * 1024; K = 2048; }
        } else if ((r -= cOUT) < 2 * cG) {
            const int up = r >= cG ? 1 : 0; if (up) r -= cG;
            WT = Wb + WO_GU; K = 1024; const int nb = r % 88, kb = r / 88; const int j0 = nb * 32;
            W = ldin(lds, up ? 6 : 5) + (size_t)L * 1024 * 2816; N = 2816; k0 = kb * 64; nsrc0 = j0; drow0 = (j0 >> 7) * 256 + (j0 & 127) + up * 128;
        } else {
            r -= 2 * cG; WT = Wb + WO_D; K = 2816; const int nb = r % 32, kb = r / 32;
            W = ldin(lds, 7) + (size_t)L * 2816 * 1024; N = 1024; k0 = kb * 64; nsrc0 = nb * 32; drow0 = nb * 32;
        }
        tr_item(W, N, k0, nsrc0, WT, K, drow0, scr, lane);
    }
    if (odd) {
        const float* W = ldin(lds, 15) + (size_t)e * 1024 * 5648; bf16_t* WT = Wb + WO_IN;
        for (int idx = gtid; idx < 16 * 1024; idx += nthr) { const int n = idx >> 10, k = idx & 1023; WT[(size_t)(2560 + n) * 1024 + k] = (bf16_t)f2bf(W[(size_t)k * 5648 + 2560 + n]); }
        unsigned* z = (unsigned*)(WT + (size_t)2576 * 1024);
        for (int idx = gtid; idx < 240 * 512; idx += nthr) z[idx] = 0u;
    }
}

__device__ __forceinline__ void ln_phase(float* X, bf16_t* XN, const float* g, const float* b, int gw, int NGW, int lane) {
    LAUNDER_V(lane); LAUNDER_S(gw);
    for (int m = gw; m < M; m += NGW) {
        float* xr = X + (size_t)m * DM + lane * 4;
        f32x4 v[4]; float s = 0.f;
#pragma unroll
        for (int j = 0; j < 4; ++j) { v[j] = *(const f32x4*)(xr + j * 256); s += (v[j][0] + v[j][1]) + (v[j][2] + v[j][3]); }
        const float mean = wave_sum(s) * (1.f / DM); float q = 0.f;
#pragma unroll
        for (int j = 0; j < 4; ++j) { v[j] = v[j] - mean; q += (v[j][0] * v[j][0] + v[j][1] * v[j][1]) + (v[j][2] * v[j][2] + v[j][3] * v[j][3]); }
        const float rstd = 1.0f / sqrtf(wave_sum(q) * (1.f / DM) + EPS);
#pragma unroll
        for (int j = 0; j < 4; ++j) { const f32x4 gg = *(const f32x4*)(g + j * 256 + lane * 4), bb = *(const f32x4*)(b + j * 256 + lane * 4);
            const f32x4 y = v[j] * rstd * gg + bb; *(f32x4*)(xr + j * 256) = y;
            u32x2 w; w.x = pk2(y[0], y[1]); w.y = pk2(y[2], y[3]); *(u32x2*)(XN + (size_t)m * DM + j * 256 + lane * 4) = w; }
    }
}

__device__ __forceinline__ void rope16(u32x4& a, u32x4& c, float pos, const float* inv) {
    float x1[8], x2[8], o1[8], o2[8]; unpack8(a, x1); unpack8(c, x2);
#pragma unroll
    for (int e = 0; e < 8; ++e) { float s, co; sincos_ang(pos * inv[e], s, co); o1[e] = x1[e] * co - x2[e] * s; o2[e] = x2[e] * co + x1[e] * s; }
    a = pack8(o1); c = pack8(o2);
}
__device__ __forceinline__ void attn_unit(LAS unsigned char* lds, const bf16_t* PR, bf16_t* MIX, const float* sinks, const float* inv_att, int b, int n, int j, int tid, int lane, int wave) {
    LAUNDER_V(tid); LAUNDER_V(lane); LAUNDER_S(wave);
    constexpr int QS = 72, VS = 264;
    LAS bf16_t* Qs = (LAS bf16_t*)lds;
    LAS bf16_t* Ks = (LAS bf16_t*)(lds + 73728);
    LAS bf16_t* Vt = (LAS bf16_t*)(lds + 73728 + 36864);
    const size_t R0 = (size_t)b * SEQ + (size_t)n * 128;
#pragma unroll 1
    for (int it = 0; it < 4; ++it) { const int idx = tid + it * 512; const int cp = idx & 3, i = (idx >> 2) & 127, g = idx >> 9;
        const bf16_t* src = PR + (R0 + i) * 1792 + (j * 4 + g) * 64 + cp * 16;
        u32x4 a = *(const u32x4*)src, c = *(const u32x4*)(src + 8);
        if (cp == 0) rope16(a, c, (float)(n * 128 + i), inv_att);
        LAS bf16_t* dst = Qs + (g * 128 + i) * QS + cp * 16; *(LAS u32x4*)dst = a; *(LAS u32x4*)(dst + 8) = c; }
#pragma unroll 1
    for (int it = 0; it < 2; ++it) { const int idx = tid + it * 512; const int cp = idx & 3, jj = idx >> 2;
        u32x4 a = (u32x4){0u, 0u, 0u, 0u}, c = a;
        if (n > 0 || jj >= 128) { const bf16_t* src = PR + (R0 + jj - 128) * 1792 + 512 + j * 64 + cp * 16; a = *(const u32x4*)src; c = *(const u32x4*)(src + 8);
            if (cp == 0) rope16(a, c, (float)(n * 128 - 128 + jj), inv_att); }
        LAS bf16_t* dst = Ks + jj * QS + cp * 16; *(LAS u32x4*)dst = a; *(LAS u32x4*)(dst + 8) = c; }
#pragma unroll 1
    for (int it = 0; it < 4; ++it) { const int idx = tid + it * 512; const int jj = idx & 255, c8 = idx >> 8;
        u32x4 a = (u32x4){0u, 0u, 0u, 0u};
        if (n > 0 || jj >= 128) a = *(const u32x4*)(PR + (R0 + jj - 128) * 1792 + 640 + j * 64 + c8 * 8);
        LAS bf16_t* dst = Vt + (c8 * 8) * VS + jj;
        dst[0 * VS] = (bf16_t)(a.x & 0xffffu); dst[1 * VS] = (bf16_t)(a.x >> 16); dst[2 * VS] = (bf16_t)(a.y & 0xffffu); dst[3 * VS] = (bf16_t)(a.y >> 16);
        dst[4 * VS] = (bf16_t)(a.z & 0xffffu); dst[5 * VS] = (bf16_t)(a.z >> 16); dst[6 * VS] = (bf16_t)(a.w & 0xffffu); dst[7 * VS] = (bf16_t)(a.w >> 16); }
    __syncthreads();
    const int fr = lane & 15, fq = lane >> 4; const int g = wave >> 1, half = (wave & 1) * 64;
    const float sink = sinks[j * 4 + g] * LOG2E; const float SC = 0.125f * LOG2E;
#pragma unroll 1
    for (int qt = 0; qt < 4; ++qt) {
        const int i0 = half + qt * 16, klo = i0 & ~31, i = i0 + fr;
        const LAS bf16_t* qp = Qs + (g * 128 + i0 + fr) * QS + fq * 8;
        const bf16x8 qf0 = *(const LAS bf16x8*)qp, qf1 = *(const LAS bf16x8*)(qp + 32);
        f32x4 s[10];
#pragma unroll
        for (int t = 0; t < 10; ++t) { const LAS bf16_t* kp = Ks + (klo + t * 16 + fr) * QS + fq * 8;
            const bf16x8 k0 = *(const LAS bf16x8*)kp, k1 = *(const LAS bf16x8*)(kp + 32);
            s[t] = mfma16(k0, qf0, (f32x4){0.f, 0.f, 0.f, 0.f}); s[t] = mfma16(k1, qf1, s[t]); }
        float mx = sink;
#pragma unroll
        for (int t = 0; t < 10; ++t)
#pragma unroll
            for (int r = 0; r < 4; ++r) { const int jj = klo + t * 16 + fq * 4 + r; const bool valid = (jj > i) && (jj <= i + 128) && (n > 0 || jj >= 128);
                const float v = valid ? s[t][r] * SC : -INFINITY; s[t][r] = v; mx = fmaxf(mx, v); }
        mx = fmaxf(mx, __shfl_xor(mx, 16)); mx = fmaxf(mx, __shfl_xor(mx, 32));
        float l = 0.f;
#pragma unroll
        for (int t = 0; t < 10; ++t)
#pragma unroll
            for (int r = 0; r < 4; ++r) { const float p = exp2f(s[t][r] - mx); s[t][r] = p; l += p; }
        l += __shfl_xor(l, 16); l += __shfl_xor(l, 32); l += exp2f(sink - mx);
        const float linv = 1.0f / l;
        bf16x8 pf[5];
#pragma unroll
        for (int ks = 0; ks < 5; ++ks) pf[ks] = packf8(s[2 * ks], s[2 * ks + 1]);
#pragma unroll
        for (int nt = 0; nt < 4; ++nt) { f32x4 o = (f32x4){0.f, 0.f, 0.f, 0.f};
#pragma unroll
            for (int ks = 0; ks < 5; ++ks) { const LAS bf16_t* vp = Vt + (nt * 16 + fr) * VS + klo + ks * 32 + fq * 4;
                const bf16x8 vf = cat44(*(const LAS bf16x4*)vp, *(const LAS bf16x4*)(vp + 16)); o = mfma16(vf, pf[ks], o); }
            u32x2 w; w.x = pk2(o[0] * linv, o[1] * linv); w.y = pk2(o[2] * linv, o[3] * linv);
            *(u32x2*)(MIX + (R0 + i0 + fr) * 1024 + (j * 4 + g) * 64 + nt * 16 + fq * 4) = w; }
    }
    __syncthreads();
}
__device__ __forceinline__ void conv_unit(LAS unsigned char* lds, const bf16_t* PR, bf16_t* MIX, const float* dw_w, const float* dw_b, const float* cn_g, const float* cn_b, int b, int tb, int tid, int lane, int wave) {
    LAUNDER_V(tid); LAUNDER_V(lane); LAUNDER_S(wave);
    LAS float* hs = (LAS float*)lds;
    const int t0 = tb * 32; const size_t Rb = (size_t)b * SEQ;
#pragma unroll 1
    for (int idx = tid; idx < 62 * 64; idx += 512) { const int c8 = idx & 63, r = idx >> 6; const int t = t0 - 30 + r;
        float h[8];
#pragma unroll
        for (int e = 0; e < 8; ++e) h[e] = 0.f;
        if (t >= 0) { const bf16_t* src = PR + (Rb + t) * 1792 + 768 + c8 * 8; const u32x4 av = *(const u32x4*)src, gv = *(const u32x4*)(src + 512);
            float a[8], gt[8]; unpack8(av, a); unpack8(gv, gt);
#pragma unroll
            for (int e = 0; e < 8; ++e) h[e] = a[e] / (1.0f + __expf(-gt[e])); }
        LAS float* dst = hs + r * 512 + c8 * 8; *(LAS f32x4*)dst = (f32x4){h[0], h[1], h[2], h[3]}; *(LAS f32x4*)(dst + 4) = (f32x4){h[4], h[5], h[6], h[7]}; }
    __syncthreads();
    { const int c = tid; float w[31];
#pragma unroll
        for (int k = 0; k < 31; ++k) w[k] = dw_w[k * 512 + c];
        const float bias = dw_b[c];
#pragma unroll 1
        for (int tt = 0; tt < 32; ++tt) { float acc = bias;
#pragma unroll
            for (int k = 0; k < 31; ++k) acc += w[k] * hs[(tt + k) * 512 + c];
            hs[tt * 512 + c] = acc; } }
    __syncthreads();
#pragma unroll 1
    for (int q = 0; q < 4; ++q) { const int tt = wave * 4 + q;
        const f32x4 v0 = *(const LAS f32x4*)(hs + tt * 512 + lane * 8), v1 = *(const LAS f32x4*)(hs + tt * 512 + lane * 8 + 4);
        float s = (v0[0] + v0[1]) + (v0[2] + v0[3]) + (v1[0] + v1[1]) + (v1[2] + v1[3]);
        const float mean = wave_sum(s) * (1.f / 512.f);
        const f32x4 d0 = v0 - mean, d1 = v1 - mean;
        float qv = (d0[0] * d0[0] + d0[1] * d0[1]) + (d0[2] * d0[2] + d0[3] * d0[3]) + (d1[0] * d1[0] + d1[1] * d1[1]) + (d1[2] * d1[2] + d1[3] * d1[3]);
        const float rstd = 1.0f / sqrtf(wave_sum(qv) * (1.f / 512.f) + EPS);
        const f32x4 g0 = *(const f32x4*)(cn_g + lane * 8), g1 = *(const f32x4*)(cn_g + lane * 8 + 4), b0 = *(const f32x4*)(cn_b + lane * 8), b1 = *(const f32x4*)(cn_b + lane * 8 + 4);
        const f32x4 y0 = d0 * rstd * g0 + b0, y1 = d1 * rstd * g1 + b1;
        u32x4 w; w.x = pk2(silu(y0[0]), silu(y0[1])); w.y = pk2(silu(y0[2]), silu(y0[3])); w.z = pk2(silu(y1[0]), silu(y1[1])); w.w = pk2(silu(y1[2]), silu(y1[3]));
        *(u32x4*)(MIX + (Rb + t0 + tt) * 1024 + 512 + lane * 8) = w; }
    __syncthreads();
}

__device__ __forceinline__ void xbc_conv8(const bf16_t* PA, size_t grow, int t, int col, const float* cw, const float* cb, int cch, float* out) {
    const f32x4 b0 = *(const f32x4*)(cb + cch), b1 = *(const f32x4*)(cb + cch + 4);
    float acc[8] = {b0[0], b0[1], b0[2], b0[3], b1[0], b1[1], b1[2], b1[3]};
#pragma unroll
    for (int k = 0; k < 4; ++k) { const int tt = t - 3 + k;
        if (tt >= 0) { const u32x4 v = *(const u32x4*)(PA + (grow + k - 3) * 2816 + col); float x[8]; unpack8(v, x);
            const f32x4 w0 = *(const f32x4*)(cw + k * 1536 + cch), w1 = *(const f32x4*)(cw + k * 1536 + cch + 4);
            acc[0] += w0[0] * x[0]; acc[1] += w0[1] * x[1]; acc[2] += w0[2] * x[2]; acc[3] += w0[3] * x[3];
            acc[4] += w1[0] * x[4]; acc[5] += w1[1] * x[5]; acc[6] += w1[2] * x[6]; acc[7] += w1[3] * x[7]; } }
#pragma unroll
    for (int e = 0; e < 8; ++e) out[e] = silu(acc[e]);
}
__device__ __forceinline__ void ssd_local_unit(LAS unsigned char* lds, const bf16_t* PA, bf16_t* ST, float* DEC, const float* cw, const float* cb, const float* dt_bias, const float* a_log,
                                               int b, int c, int h, int tid, int lane, int wave) {
    LAUNDER_V(tid); LAUNDER_V(lane); LAUNDER_S(wave);
    constexpr int RS = 136;
    LAS bf16_t* XT = (LAS bf16_t*)lds;
    LAS bf16_t* BT = (LAS bf16_t*)(lds + 17408);
    LAS float* dts = (LAS float*)(lds + 52224); LAS float* das = dts + 128; LAS float* acs = das + 128;
    const int g = h >> 3; const size_t row0 = (size_t)b * SEQ + (size_t)c * 128; const int t0 = c * 128;
    if (tid < 128) { const float raw = bf2f(PA[(row0 + tid) * 2816 + 2560 + h]) + dt_bias[h]; const float dt = softplus(raw); dts[tid] = dt; das[tid] = -dt * __expf(a_log[h]); }
    __syncthreads();
    if (tid < 128) { float s = 0.f; for (int l = 0; l <= tid; ++l) s += das[l]; acs[tid] = s; }
    __syncthreads();
    const float total = acs[127];
#pragma unroll 1
    for (int it = 0; it < 2; ++it) { const int idx = tid + it * 512; const int l = idx & 127, pc = idx >> 7; float v[8];
        xbc_conv8(PA, row0 + l, t0 + l, 1024 + h * 64 + pc * 8, cw, cb, h * 64 + pc * 8, v);
        const float f = dts[l] * __expf(total - acs[l]);
#pragma unroll
        for (int e = 0; e < 8; ++e) XT[(pc * 8 + e) * RS + l] = (bf16_t)f2bf(v[e] * f); }
#pragma unroll 1
    for (int it = 0; it < 4; ++it) { const int idx = tid + it * 512; const int l = idx & 127, nc = idx >> 7; float v[8];
        xbc_conv8(PA, row0 + l, t0 + l, 2048 + g * 128 + nc * 8, cw, cb, 1024 + g * 128 + nc * 8, v);
#pragma unroll
        for (int e = 0; e < 8; ++e) BT[(nc * 8 + e) * RS + l] = (bf16_t)f2bf(v[e]); }
    __syncthreads();
    const int fr = lane & 15, fq = lane >> 4;
    f32x4 acc[4];
#pragma unroll
    for (int pt = 0; pt < 4; ++pt) acc[pt] = (f32x4){0.f, 0.f, 0.f, 0.f};
#pragma unroll
    for (int ks = 0; ks < 4; ++ks) { const bf16x8 bfg = *(const LAS bf16x8*)(BT + (wave * 16 + fr) * RS + ks * 32 + fq * 8);
#pragma unroll
        for (int pt = 0; pt < 4; ++pt) { const bf16x8 xf = *(const LAS bf16x8*)(XT + (pt * 16 + fr) * RS + ks * 32 + fq * 8); acc[pt] = mfma16(bfg, xf, acc[pt]); } }
    bf16_t* dst = ST + ((size_t)((b * 128 + c) * 16 + h)) * 8192;
#pragma unroll
    for (int pt = 0; pt < 4; ++pt) { u32x2 w; w.x = pk2(acc[pt][0], acc[pt][1]); w.y = pk2(acc[pt][2], acc[pt][3]); *(u32x2*)(dst + (pt * 16 + fr) * 128 + wave * 16 + fq * 4) = w; }
    if (tid == 0) DEC[(b * 128 + c) * 16 + h] = __expf(total);
    __syncthreads();
}
__device__ __forceinline__ void scan_phase(bf16_t* ST, const float* DEC, int mode, int gtid, int nthr) {
    LAUNDER_V(gtid);
    for (int e2 = gtid; e2 < 131072; e2 += nthr) {
        const int b = e2 >> 16, eb = e2 & 65535; const int h = mode ? (eb >> 14) : (eb >> 12);
        unsigned* p = (unsigned*)ST + (size_t)b * 128 * 65536 + eb;
        const float dconst = exp2f(128.f * log2gamma(h & 3));
        const float* dp = DEC + b * 128 * 16 + (h & 15);
        float c0 = 0.f, c1 = 0.f;
#pragma unroll 1
        for (int c = 0; c < 128; c += 8) { unsigned v[8]; float d[8];
#pragma unroll
            for (int k = 0; k < 8; ++k) { v[k] = p[(size_t)(c + k) * 65536]; d[k] = mode ? dconst : dp[(c + k) * 16]; }
#pragma unroll
            for (int k = 0; k < 8; ++k) { p[(size_t)(c + k) * 65536] = pk2(c0, c1); c0 = c0 * d[k] + bflo(v[k]); c1 = c1 * d[k] + bfhi(v[k]); } }
    }
}
__device__ __forceinline__ void ssd_out_unit(LAS unsigned char* lds, const bf16_t* PA, const bf16_t* ST, bf16_t* MIX, const float* cw, const float* cb, const float* dt_bias, const float* a_log,
                                             const float* d_skip, const float* norm_g, int b, int c, int g, int tid, int lane, int wave) {
    LAUNDER_V(tid); LAUNDER_V(lane); LAUNDER_S(wave);
    constexpr int RS = 136, XR = 72;
    LAS bf16_t* Cs = (LAS bf16_t*)lds;
    LAS bf16_t* Bs = (LAS bf16_t*)(lds + 34816);
    LAS bf16_t* XT = (LAS bf16_t*)(lds + 69632);
    LAS bf16_t* PV = (LAS bf16_t*)(lds + 87040);
    LAS bf16_t* XS = (LAS bf16_t*)(lds + 104448);
    LAS float* dts = (LAS float*)(lds + 122880);
    LAS float* acs = (LAS float*)(lds + 126976);
    LAS float* tmp = (LAS float*)(lds + 69632);
    const size_t row0 = (size_t)b * SEQ + (size_t)c * 128; const int t0 = c * 128;
#pragma unroll 1
    for (int it = 0; it < 2; ++it) { const int idx = tid + it * 512; const int hg = idx >> 7, l = idx & 127, h = g * 8 + hg;
        const float raw = bf2f(PA[(row0 + l) * 2816 + 2560 + h]) + dt_bias[h]; const float dt = softplus(raw); dts[idx] = dt; tmp[idx] = -dt * __expf(a_log[h]); }
    __syncthreads();
#pragma unroll 1
    for (int it = 0; it < 2; ++it) { const int idx = tid + it * 512; const int hb = idx & ~127, l = idx & 127; float s = 0.f; for (int q = 0; q <= l; ++q) s += tmp[hb + q]; acs[idx] = s; }
#pragma unroll 1
    for (int it = 0; it < 4; ++it) { const int idx = tid + it * 512; const int nc = idx & 15, l = idx >> 4; float v[8];
        xbc_conv8(PA, row0 + l, t0 + l, 2304 + g * 128 + nc * 8, cw, cb, 1280 + g * 128 + nc * 8, v); *(LAS u32x4*)(Cs + l * RS + nc * 8) = pack8(v);
        xbc_conv8(PA, row0 + l, t0 + l, 2048 + g * 128 + nc * 8, cw, cb, 1024 + g * 128 + nc * 8, v); *(LAS u32x4*)(Bs + l * RS + nc * 8) = pack8(v); }
    __syncthreads();
    const int fr = lane & 15, fq = lane >> 4; const int l = wave * 16 + fr; const int wodd = wave | 1, nk2 = wave >> 1;
    f32x4 cbt[8];
#pragma unroll
    for (int st = 0; st < 8; ++st) { cbt[st] = (f32x4){0.f, 0.f, 0.f, 0.f};
        if (st <= wodd) {
#pragma unroll
            for (int ks = 0; ks < 4; ++ks) { const bf16x8 af = *(const LAS bf16x8*)(Bs + (st * 16 + fr) * RS + ks * 32 + fq * 8), bf = *(const LAS bf16x8*)(Cs + l * RS + ks * 32 + fq * 8);
                cbt[st] = mfma16(af, bf, cbt[st]); } } }
    float ssq = 0.f;
#pragma unroll 1
    for (int hg = 0; hg < 8; ++hg) {
        const int h = g * 8 + hg;
        __syncthreads();
#pragma unroll 1
        for (int it = 0; it < 2; ++it) { const int idx = tid + it * 512; const int ll = idx & 127, pc = idx >> 7; float v[8];
            xbc_conv8(PA, row0 + ll, t0 + ll, 1024 + h * 64 + pc * 8, cw, cb, h * 64 + pc * 8, v);
            *(LAS u32x4*)(XS + ll * XR + pc * 8) = pack8(v);
            const float dt = dts[hg * 128 + ll];
#pragma unroll
            for (int e = 0; e < 8; ++e) XT[(pc * 8 + e) * RS + ll] = (bf16_t)f2bf(v[e] * dt); }
        { const bf16_t* src = ST + ((size_t)((b * 128 + c) * 16 + h)) * 8192;
#pragma unroll 1
            for (int it = 0; it < 2; ++it) { const int idx = tid + it * 512; const int nc = idx & 15, p = idx >> 4; *(LAS u32x4*)(PV + p * RS + nc * 8) = *(const u32x4*)(src + p * 128 + nc * 8); } }
        __syncthreads();
        int lc = l; LAUNDER_V(lc);
        const LAS float* ah = acs + hg * 128; const float al = ah[l];
        f32x4 accd[4], acco[4];
#pragma unroll
        for (int pt = 0; pt < 4; ++pt) { accd[pt] = (f32x4){0.f, 0.f, 0.f, 0.f}; acco[pt] = (f32x4){0.f, 0.f, 0.f, 0.f}; }
#pragma unroll
        for (int k2 = 0; k2 < 4; ++k2) {
            if (k2 <= nk2) {
                const int s0 = k2 * 32 + fq * 4, s1 = s0 + 16;
                const f32x4 a0 = *(const LAS f32x4*)(ah + s0), a1 = *(const LAS f32x4*)(ah + s1);
                f32x4 p0, p1;
#pragma unroll
                for (int r = 0; r < 4; ++r) { p0[r] = (s0 + r <= lc) ? cbt[2 * k2][r] * __expf(fminf(al - a0[r], 0.f)) : 0.f; p1[r] = (s1 + r <= lc) ? cbt[2 * k2 + 1][r] * __expf(fminf(al - a1[r], 0.f)) : 0.f; }
                const bf16x8 pf = packf8(p0, p1);
#pragma unroll
                for (int pt = 0; pt < 4; ++pt) { const LAS bf16_t* xp = XT + (pt * 16 + fr) * RS + s0;
                    const bf16x8 xf = cat44(*(const LAS bf16x4*)xp, *(const LAS bf16x4*)(xp + 16)); accd[pt] = mfma16(xf, pf, accd[pt]); }
            }
        }
#pragma unroll
        for (int ks = 0; ks < 4; ++ks) { const bf16x8 cf = *(const LAS bf16x8*)(Cs + l * RS + ks * 32 + fq * 8);
#pragma unroll
            for (int pt = 0; pt < 4; ++pt) { const bf16x8 pvf = *(const LAS bf16x8*)(PV + (pt * 16 + fr) * RS + ks * 32 + fq * 8); acco[pt] = mfma16(pvf, cf, acco[pt]); } }
        const float el = __expf(al), dsk = d_skip[h];
#pragma unroll
        for (int pt = 0; pt < 4; ++pt) { const int p = pt * 16 + fq * 4;
            const u32x2 xv = *(const LAS u32x2*)(XS + l * XR + p); const u32x2 zv = *(const u32x2*)(PA + (row0 + l) * 2816 + h * 64 + p);
            const float xs0 = bflo(xv.x), xs1 = bfhi(xv.x), xs2 = bflo(xv.y), xs3 = bfhi(xv.y);
            float y0 = accd[pt][0] + el * acco[pt][0] + dsk * xs0, y1 = accd[pt][1] + el * acco[pt][1] + dsk * xs1, y2 = accd[pt][2] + el * acco[pt][2] + dsk * xs2, y3 = accd[pt][3] + el * acco[pt][3] + dsk * xs3;
            y0 *= silu(bflo(zv.x)); y1 *= silu(bfhi(zv.x)); y2 *= silu(bflo(zv.y)); y3 *= silu(bfhi(zv.y));
            ssq += (y0 * y0 + y1 * y1) + (y2 * y2 + y3 * y3);
            u32x2 w; w.x = pk2(y0, y1); w.y = pk2(y2, y3); *(u32x2*)(MIX + (row0 + l) * 2048 + h * 64 + p) = w; }
    }
    ssq += __shfl_xor(ssq, 16); ssq += __shfl_xor(ssq, 32);
    const float rstd = 1.0f / sqrtf(ssq * (1.f / 512.f) + EPS);
#pragma unroll 1
    for (int hg = 0; hg < 8; ++hg)
#pragma unroll
        for (int pt = 0; pt < 4; ++pt) { const int ch = (g * 8 + hg) * 64 + pt * 16 + fq * 4; u32x2* q = (u32x2*)(MIX + (row0 + l) * 2048 + ch); const u32x2 v = *q; const f32x4 ng = *(const f32x4*)(norm_g + ch);
            u32x2 w; w.x = pk2(bflo(v.x) * rstd * ng[0], bfhi(v.x) * rstd * ng[1]); w.y = pk2(bflo(v.y) * rstd * ng[2], bfhi(v.y) * rstd * ng[3]); *q = w; }
    __syncthreads();
}

__device__ __forceinline__ void rope_pair8(const bf16_t* src, float pos, const float* inv, float scale, float* o1, float* o2) {
    const u32x4 av = *(const u32x4*)src, cv = *(const u32x4*)(src + 64); float x1[8], x2[8]; unpack8(av, x1); unpack8(cv, x2);
#pragma unroll
    for (int e = 0; e < 8; ++e) { float s, co; sincos_ang(pos * inv[e], s, co); o1[e] = (x1[e] * co - x2[e] * s) * scale; o2[e] = (x2[e] * co + x1[e] * s) * scale; }
}
__device__ __forceinline__ void ret_local_unit(LAS unsigned char* lds, const bf16_t* PB, bf16_t* ST, const float* inv_ret, int b, int c, int h, int tid, int lane, int wave) {
    LAUNDER_V(tid); LAUNDER_V(lane); LAUNDER_S(wave);
    constexpr int RS = 136;
    LAS bf16_t* VT = (LAS bf16_t*)lds;
    LAS bf16_t* KT = (LAS bf16_t*)(lds + 69632);
    const size_t row0 = (size_t)b * SEQ + (size_t)c * 128; const float lg = log2gamma(h);
#pragma unroll 1
    for (int it = 0; it < 2; ++it) { const int idx = tid + it * 512; const int l = idx & 127, ic = idx >> 7; float o1[8], o2[8];
        rope_pair8(PB + (row0 + l) * 3072 + 512 + h * 128 + ic * 8, (float)(c * 128 + l), inv_ret + ic * 8, 0.08838834764831845f * exp2f((float)(127 - l) * lg), o1, o2);
#pragma unroll
        for (int e = 0; e < 8; ++e) { KT[(ic * 8 + e) * RS + l] = (bf16_t)f2bf(o1[e]); KT[(64 + ic * 8 + e) * RS + l] = (bf16_t)f2bf(o2[e]); } }
#pragma unroll 1
    for (int it = 0; it < 8; ++it) { const int idx = tid + it * 512; const int l = idx & 127, vc = idx >> 7;
        const u32x4 a = *(const u32x4*)(PB + (row0 + l) * 3072 + 1024 + h * 256 + vc * 8); LAS bf16_t* dst = VT + (vc * 8) * RS + l;
        dst[0 * RS] = (bf16_t)(a.x & 0xffffu); dst[1 * RS] = (bf16_t)(a.x >> 16); dst[2 * RS] = (bf16_t)(a.y & 0xffffu); dst[3 * RS] = (bf16_t)(a.y >> 16);
        dst[4 * RS] = (bf16_t)(a.z & 0xffffu); dst[5 * RS] = (bf16_t)(a.z >> 16); dst[6 * RS] = (bf16_t)(a.w & 0xffffu); dst[7 * RS] = (bf16_t)(a.w >> 16); }
    __syncthreads();
    const int fr = lane & 15, fq = lane >> 4;
    f32x4 acc[2][8];
#pragma unroll
    for (int vi = 0; vi < 2; ++vi)
#pragma unroll
        for (int dt = 0; dt < 8; ++dt) acc[vi][dt] = (f32x4){0.f, 0.f, 0.f, 0.f};
#pragma unroll
    for (int ks = 0; ks < 4; ++ks) { bf16x8 vf[2];
#pragma unroll
        for (int vi = 0; vi < 2; ++vi) vf[vi] = *(const LAS bf16x8*)(VT + ((2 * wave + vi) * 16 + fr) * RS + ks * 32 + fq * 8);
#pragma unroll
        for (int dt = 0; dt < 8; ++dt) { const bf16x8 kf = *(const LAS bf16x8*)(KT + (dt * 16 + fr) * RS + ks * 32 + fq * 8);
#pragma unroll
            for (int vi = 0; vi < 2; ++vi) acc[vi][dt] = mfma16(kf, vf[vi], acc[vi][dt]); } }
    bf16_t* dst = ST + ((size_t)((b * 128 + c) * 4 + h)) * 32768;
#pragma unroll
    for (int vi = 0; vi < 2; ++vi)
#pragma unroll
        for (int dt = 0; dt < 8; ++dt) { u32x2 w; w.x = pk2(acc[vi][dt][0], acc[vi][dt][1]); w.y = pk2(acc[vi][dt][2], acc[vi][dt][3]); *(u32x2*)(dst + ((2 * wave + vi) * 16 + fr) * 128 + dt * 16 + fq * 4) = w; }
    __syncthreads();
}
__device__ __forceinline__ void ret_out_unit(LAS unsigned char* lds, const bf16_t* PB, const bf16_t* ST, bf16_t* MIX, const float* inv_ret, const float* gn_g, const float* gn_b,
                                             int b, int c, int h, int tid, int lane, int wave) {
    LAUNDER_V(tid); LAUNDER_V(lane); LAUNDER_S(wave);
    constexpr int RS = 136;
    LAS bf16_t* Qs = (LAS bf16_t*)lds;
    LAS bf16_t* Ks = (LAS bf16_t*)(lds + 34816);
    LAS bf16_t* VT = (LAS bf16_t*)(lds + 69632);
    LAS bf16_t* PV = (LAS bf16_t*)(lds + 104448);
    const size_t row0 = (size_t)b * SEQ + (size_t)c * 128; const float lg = log2gamma(h);
    const bf16_t* stsrc = ST + ((size_t)((b * 128 + c) * 4 + h)) * 32768;
#pragma unroll 1
    for (int it = 0; it < 2; ++it) { const int idx = tid + it * 512; const int ic = idx & 7, l = idx >> 3; float o1[8], o2[8]; const float pos = (float)(c * 128 + l);
        rope_pair8(PB + (row0 + l) * 3072 + h * 128 + ic * 8, pos, inv_ret + ic * 8, 1.0f, o1, o2);
        *(LAS u32x4*)(Qs + l * RS + ic * 8) = pack8(o1); *(LAS u32x4*)(Qs + l * RS + 64 + ic * 8) = pack8(o2);
        rope_pair8(PB + (row0 + l) * 3072 + 512 + h * 128 + ic * 8, pos, inv_ret + ic * 8, 0.08838834764831845f, o1, o2);
        *(LAS u32x4*)(Ks + l * RS + ic * 8) = pack8(o1); *(LAS u32x4*)(Ks + l * RS + 64 + ic * 8) = pack8(o2); }
    const int fr = lane & 15, fq = lane >> 4; const int l = wave * 16 + fr; const int wodd = wave | 1, nk2 = wave >> 1;
    f32x4 acc[16];
#pragma unroll
    for (int vt = 0; vt < 16; ++vt) acc[vt] = (f32x4){0.f, 0.f, 0.f, 0.f};
    bf16x8 pf[4], qs[4];
#pragma unroll
    for (int vh = 0; vh < 2; ++vh) {
        if (vh == 1) __syncthreads();
#pragma unroll 1
        for (int it = 0; it < 4; ++it) { const int idx = tid + it * 512; const int s = idx & 127, vc = idx >> 7;
            const u32x4 a = *(const u32x4*)(PB + (row0 + s) * 3072 + 1024 + h * 256 + vh * 128 + vc * 8); LAS bf16_t* dst = VT + (vc * 8) * RS + s;
            dst[0 * RS] = (bf16_t)(a.x & 0xffffu); dst[1 * RS] = (bf16_t)(a.x >> 16); dst[2 * RS] = (bf16_t)(a.y & 0xffffu); dst[3 * RS] = (bf16_t)(a.y >> 16);
            dst[4 * RS] = (bf16_t)(a.z & 0xffffu); dst[5 * RS] = (bf16_t)(a.z >> 16); dst[6 * RS] = (bf16_t)(a.w & 0xffffu); dst[7 * RS] = (bf16_t)(a.w >> 16); }
#pragma unroll 1
        for (int it = 0; it < 4; ++it) { const int idx = tid + it * 512; const int dc = idx & 15, v = idx >> 4; *(LAS u32x4*)(PV + v * RS + dc * 8) = *(const u32x4*)(stsrc + (vh * 128 + v) * 128 + dc * 8); }
        __syncthreads();
        if (vh == 0) {
            f32x4 sc[8];
#pragma unroll
            for (int st = 0; st < 8; ++st) { sc[st] = (f32x4){0.f, 0.f, 0.f, 0.f};
                if (st <= wodd) {
#pragma unroll
                    for (int ks = 0; ks < 4; ++ks) { const bf16x8 kf = *(const LAS bf16x8*)(Ks + (st * 16 + fr) * RS + ks * 32 + fq * 8), qf = *(const LAS bf16x8*)(Qs + l * RS + ks * 32 + fq * 8);
                        sc[st] = mfma16(kf, qf, sc[st]); } } }
#pragma unroll
            for (int k2 = 0; k2 < 4; ++k2) { f32x4 p0, p1; const int s0 = k2 * 32 + fq * 4, s1 = s0 + 16;
#pragma unroll
                for (int r = 0; r < 4; ++r) { p0[r] = (s0 + r <= l) ? sc[2 * k2][r] * exp2f((float)(l - s0 - r) * lg) : 0.f; p1[r] = (s1 + r <= l) ? sc[2 * k2 + 1][r] * exp2f((float)(l - s1 - r) * lg) : 0.f; }
                pf[k2] = packf8(p0, p1); }
            const float fs = exp2f((float)(l + 1) * lg);
#pragma unroll
            for (int ks = 0; ks < 4; ++ks) { const u32x4 qv = *(const LAS u32x4*)(Qs + l * RS + ks * 32 + fq * 8); float x[8]; unpack8(qv, x);
#pragma unroll
                for (int e = 0; e < 8; ++e) x[e] *= fs;
                qs[ks] = __builtin_bit_cast(bf16x8, pack8(x)); }
        }
#pragma unroll
        for (int vt = 0; vt < 8; ++vt) { f32x4 a = acc[vh * 8 + vt];
#pragma unroll
            for (int ks = 0; ks < 4; ++ks) { const bf16x8 pvf = *(const LAS bf16x8*)(PV + (vt * 16 + fr) * RS + ks * 32 + fq * 8); a = mfma16(pvf, qs[ks], a); }
#pragma unroll
            for (int k2 = 0; k2 < 4; ++k2) { if (k2 <= nk2) { const LAS bf16_t* vp = VT + (vt * 16 + fr) * RS + k2 * 32 + fq * 4;
                    const bf16x8 vf = cat44(*(const LAS bf16x4*)vp, *(const LAS bf16x4*)(vp + 16)); a = mfma16(vf, pf[k2], a); } }
            acc[vh * 8 + vt] = a; __builtin_amdgcn_sched_barrier(0); }
    }
    float s = 0.f;
#pragma unroll
    for (int vt = 0; vt < 16; ++vt) s += (acc[vt][0] + acc[vt][1]) + (acc[vt][2] + acc[vt][3]);
    s += __shfl_xor(s, 16); s += __shfl_xor(s, 32);
    const float mean = s * (1.f / 256.f); float qv = 0.f;
#pragma unroll
    for (int vt = 0; vt < 16; ++vt) { acc[vt] = acc[vt] - mean; qv += (acc[vt][0] * acc[vt][0] + acc[vt][1] * acc[vt][1]) + (acc[vt][2] * acc[vt][2] + acc[vt][3] * acc[vt][3]); }
    qv += __shfl_xor(qv, 16); qv += __shfl_xor(qv, 32);
    const float rstd = 1.0f / sqrtf(qv * (1.f / 256.f) + EPS);
#pragma unroll
    for (int vt = 0; vt < 16; ++vt) { const int ch = h * 256 + vt * 16 + fq * 4;
        const u32x2 gv = *(const u32x2*)(PB + (row0 + l) * 3072 + 2048 + ch); const f32x4 gg = *(const f32x4*)(gn_g + ch), gb = *(const f32x4*)(gn_b + ch);
        const f32x4 y = acc[vt] * rstd * gg + gb;
        u32x2 w; w.x = pk2(silu(bflo(gv.x)) * y[0], silu(bfhi(gv.x)) * y[1]); w.y = pk2(silu(bflo(gv.y)) * y[2], silu(bfhi(gv.y)) * y[3]);
        *(u32x2*)(MIX + (row0 + l) * 2048 + 1024 + ch) = w; }
    __syncthreads();
}

#define GSYNC() do { __builtin_amdgcn_fence(__ATOMIC_RELEASE, "agent"); grid.sync(); __builtin_amdgcn_fence(__ATOMIC_ACQUIRE, "agent"); } while (0)

__global__ void __launch_bounds__(512, 2) mega_fwd(Params P) {
    extern __shared__ __attribute__((aligned(16))) unsigned char lds_raw[];
    LAS unsigned char* lds = (LAS unsigned char*)lds_raw;
    cg::grid_group grid = cg::this_grid();
    const int tid = threadIdx.x, lane = tid & 63, wave = __builtin_amdgcn_readfirstlane(tid >> 6);
    const int G = gridDim.x, bid = blockIdx.x, gw = bid * 8 + wave, NGW = G * 8, gtid = bid * 512 + tid, nthr = G * 512;
    if (tid == 0) { volatile LAS unsigned long long* t = (volatile LAS unsigned long long*)(lds + PTR_OFF);
#pragma unroll
        for (int i = 0; i < 25; ++i) t[i] = (unsigned long long)P.in[i];
        t[25] = (unsigned long long)P.out; t[26] = (unsigned long long)P.ws; }
    __syncthreads();
#define Wb ((bf16_t*)(ldws(lds) + WS_W))
#define XN ((bf16_t*)(ldws(lds) + WS_XN))
#define PROJ ((bf16_t*)(ldws(lds) + WS_PROJ))
#define MIX ((bf16_t*)(ldws(lds) + WS_MIX))
#define ST ((bf16_t*)(ldws(lds) + WS_ST))
#define DEC ((float*)(ldws(lds) + WS_DEC))
#define TAB ((float*)(ldws(lds) + WS_TAB))
#define X (ldout(lds))

    { const float* x = ldin(lds, 0);
        for (size_t i = (size_t)gtid; i < (size_t)M * DM / 8; i += (size_t)nthr) { const f32x4 a = *(const f32x4*)(x + i * 8), c = *(const f32x4*)(x + i * 8 + 4);
            u32x4 w; w.x = pk2(a[0], a[1]); w.y = pk2(a[2], a[3]); w.z = pk2(c[0], c[1]); w.w = pk2(c[2], c[3]); *(u32x4*)(XN + i * 8) = w; }
        if (bid == 0 && tid < 72) {
            float v;
            if (tid < 64) { const float t = (float)tid * (1.0f / 63.0f); v = 1.0f / (float)pow(10000.0, (double)t); }
            else { v = (float)pow(500000.0, -(double)(tid - 64) / 8.0); }
            TAB[tid] = v; }
        convert_layer(0, lds, gw, NGW, lane, wave, gtid, nthr);
    }
    GSYNC();

#pragma unroll 1
    for (int L = 0; L < 4; ++L) {
        const int e = L >> 1; const bool odd = (L & 1) != 0;
#pragma unroll 1
        for (int part = 0; part < 2; ++part) {
            if (part == 0) {
                const int nsub = odd ? 2 : 1;
#pragma unroll 1
                for (int sub = 0; sub < nsub; ++sub) {
                    const int N = odd ? (sub ? 3072 : 2816) : 1792;
                    { pg8::Gemm gm{XN, Wb + WO_IN + (size_t)(sub ? 2816 : 0) * 1024, M, N, 1024}; pg8::StaticOrder S; int bl = bid; LAUNDER_S(bl); S.init(M, N, G, bl);
                        pg8::EpiBf16<0> E{PROJ, N, nullptr, 0, 0, 1.f};
                        pg8::gemm_phase<pg8::EpiBf16<0>, pg8::StaticOrder, true, true>(lds, gm, S, E); }
                    GSYNC();
                    if (!odd) {

#ifndef NO_ATTN
for (int u = bid; u < 512; u += G) attn_unit(lds, PROJ, MIX, ldin(lds, 9) + e * 8, TAB + 64, u >> 8, (u >> 1) & 127, u & 1, tid, lane, wave);
#endif


#ifndef NO_CONV
for (int u = bid; u < 1024; u += G) conv_unit(lds, PROJ, MIX, ldin(lds, 10) + (size_t)e * 31 * 512, ldin(lds, 11) + e * 512, ldin(lds, 12) + e * 512, ldin(lds, 13) + e * 512, u >> 9, u & 511, tid, lane, wave);
#endif

                        GSYNC();
                    } else if (sub == 0) {
                        const float* cw = ldin(lds, 16) + (size_t)e * 4 * 1536; const float* cb = ldin(lds, 17) + e * 1536; const float* dtb = ldin(lds, 18) + e * 16; const float* alog = ldin(lds, 19) + e * 16;

#ifndef NO_SSDL
for (int u = bid; u < 4096; u += G) ssd_local_unit(lds, PROJ, ST, DEC, cw, cb, dtb, alog, u >> 11, (u >> 4) & 127, u & 15, tid, lane, wave);
#endif

                        GSYNC();

#ifndef NO_SCAN
scan_phase(ST, DEC, 0, gtid, nthr);
#endif

                        GSYNC();

#ifndef NO_SSDO
for (int u = bid; u < 512; u += G) ssd_out_unit(lds, PROJ, ST, MIX, cw, cb, dtb, alog, ldin(lds, 20) + e * 16, ldin(lds, 21) + e * 1024, u >> 8, (u >> 1) & 127, u & 1, tid, lane, wave);
#endif

                        GSYNC();
                    } else {

#ifndef NO_RETL
for (int u = bid; u < 1024; u += G) ret_local_unit(lds, PROJ, ST, TAB, u >> 9, (u >> 2) & 127, u & 3, tid, lane, wave);
#endif

                        GSYNC();

#ifndef NO_SCAN
scan_phase(ST, DEC, 1, gtid, nthr);
#endif

                        GSYNC();

#ifndef NO_RETO
for (int u = bid; u < 1024; u += G) ret_out_unit(lds, PROJ, ST, MIX, TAB, ldin(lds, 22) + e * 1024, ldin(lds, 23) + e * 1024, u >> 9, (u >> 2) & 127, u & 3, tid, lane, wave);
#endif

                        GSYNC();
                    }
                }
            } else {
                pg8::Gemm gm{XN, Wb + WO_GU, M, 5632, 1024}; pg8::StaticOrder S; int bl = bid; LAUNDER_S(bl); S.init(M, 5632, G, bl);
                pg8::EpiSwiglu E{PROJ, FFH};
                pg8::gemm_phase<pg8::EpiSwiglu, pg8::StaticOrder, true, true>(lds, gm, S, E);
                GSYNC();
            }
            {
                const int K = part ? FFH : (odd ? 2048 : 1024);
                pg8::Gemm gm{part ? PROJ : MIX, Wb + (part ? WO_D : WO_OUT), M, 1024, K}; pg8::StaticOrder S; int bl = bid; LAUNDER_S(bl); S.init(M, 1024, G, bl);
                pg8::EpiRes E{(L == 0 && part == 0) ? ldin(lds, 0) : X, X, 1024, ALPHA};
                pg8::gemm_phase<pg8::EpiRes, pg8::StaticOrder, true, true>(lds, gm, S, E);
            }
            GSYNC();

#ifndef NO_LN
ln_phase(X, XN, ldin(lds, part ? 3 : 1) + L * 1024, ldin(lds, part ? 4 : 2) + L * 1024, gw, NGW, lane);
#endif


#ifndef NO_CVT
if (part == 1 && L < 3) convert_layer(L + 1, lds, gw, NGW, lane, wave, gtid, nthr);
#endif

            GSYNC();
        }
    }
}
}

extern "C" void kernel_launch(void* const* d_in, const int* in_sizes, int n_in, void* d_out, int out_size, void* d_ws, size_t ws_size, hipStream_t stream) {
    static int grid = 0;
    if (grid == 0) {
        int dev = 0, cus = 0, per_cu = 0;
        hipGetDevice(&dev); hipDeviceGetAttribute(&cus, hipDeviceAttributeMultiprocessorCount, dev);
        hipFuncSetAttribute((const void*)mk::mega_fwd, hipFuncAttributeMaxDynamicSharedMemorySize, mk::LDS_BYTES);
        hipOccupancyMaxActiveBlocksPerMultiprocessor(&per_cu, (const void*)mk::mega_fwd, 512, mk::LDS_BYTES);
        if (per_cu < 1) per_cu = 1;
        (void)hipGetLastError();
        grid = cus * 1;
        if (grid <= 0) grid = 256;
    }
    mk::Params p{};
    for (int i = 0; i < 25; ++i) p.in[i] = (const float*)d_in[i];
    p.out = (float*)d_out; p.ws = (unsigned char*)d_ws;
    void* args[] = {&p};
    hipError_t err = hipLaunchCooperativeKernel((const void*)mk::mega_fwd, dim3(grid), dim3(512), args, mk::LDS_BYTES, stream);
    if (err != hipSuccess) fprintf(stderr, "cooperative launch failed: %s (grid %d)\n", hipGetErrorString(err), grid);
}
```

```cpp
#include <hip/hip_runtime.h>
#include <hip/hip_cooperative_groups.h>
#include <cstdio>
#include <cstdint>
#include <cmath>
namespace pg8 {
#define PG8_LAS __attribute__((address_space(3)))
typedef unsigned short bf16_t;
typedef short bf16x8 __attribute__((ext_vector_type(8)));
typedef float f32x4 __attribute__((ext_vector_type(4)));
typedef unsigned u32x4 __attribute__((ext_vector_type(4)));
constexpr int BM = 256, BK = 64, HALF = 128, HTB = HALF * BK * 2  , STAGE_BYTES = 8 * HTB, NXCD = 8, WGM = 8;

__host__ __device__ __forceinline__ int lds_byte(int r, int c) { const int st = (r >> 4) * 2 + (c >> 5), rr = r & 15, cc = c & 31, ob = rr * 64 + cc * 2; return st * 1024 + (ob ^ (((ob >> 9) & 1) << 5)); }
__host__ __device__ __forceinline__ void stage_rc(int b, int& R, int& C) { const int st = b / 1024, sb = b % 1024, swz = sb ^ (((sb >> 9) & 1) << 5); R = (st >> 1) * 16 + swz / 64; C = (st & 1) * 32 + (swz % 64) / 2; }
__host__ __device__ __forceinline__ int perm32(int rho) { const int n = rho >> 4, i = rho & 15; return 8 * (i >> 2) + 4 * n + (i & 3); }

struct Unit { int pm, pn; };
struct Gemm { const bf16_t* A; const bf16_t* Bt; int M, N, K; };

struct StaticOrder {
    int nM, nN, nwg, G, c;
    __host__ __device__ void init(int M, int N, int G_, int c_) { nM = M / BM; nN = N / BM; nwg = nM * nN; G = G_; c = c_; }
    __host__ __device__ bool next(int i, Unit& u) const {
        const long L = (long)i * G + c; if (L >= nwg) return false;
        int wgid = (int)L; { const int q = nwg / NXCD, r = nwg % NXCD, xcd = wgid % NXCD, off = wgid / NXCD; wgid = (xcd < r ? xcd * (q + 1) : r * (q + 1) + (xcd - r) * q) + off; }
        const int nig = WGM * nN, gid = wgid / nig, fm = gid * WGM, gsz = (nM - fm) < WGM ? (nM - fm) : WGM;
        u.pm = fm + ((wgid % nig) % gsz); u.pn = (wgid % nig) / gsz; return true;
    }
    __device__ __forceinline__ void a_ready(const Unit&) const {}
    __device__ __forceinline__ void done(const Unit&) const {}
};

__device__ __forceinline__ unsigned cvt_pk_bf16(float lo, float hi) { unsigned r; asm volatile("v_cvt_pk_bf16_f32 %0, %1, %2" : "=v"(r) : "v"(lo), "v"(hi)); return r; }
typedef float f32x2 __attribute__((ext_vector_type(2)));
__device__ __forceinline__ f32x2 gelu_pk(f32x2 v) {
    const f32x2 av = __builtin_elementwise_abs(v), d = av * 0.2316418882f + 1.0f;
    f32x2 t; t.x = __builtin_amdgcn_rcpf(d.x); t.y = __builtin_amdgcn_rcpf(d.y);
    f32x2 q = t * 0.5307027145f + (-0.7265760135f); q = q * t + 0.7107068705f; q = q * t + (-0.142248368f); q = q * t + 0.127414796f; q = q * t;
    const f32x2 s = (v * v) * (-0.72134752044f);
    f32x2 e; e.x = __builtin_amdgcn_exp2f(s.x); e.y = __builtin_amdgcn_exp2f(s.y);
    const f32x2 m = v * (q * e), r = v - m;
    f32x2 o; o.x = v.x < 0.f ? m.x : r.x; o.y = v.y < 0.f ? m.y : r.y; return o;
}

template <int ACT  > struct EpiBf16 {
    static constexpr bool PERM = true, AFTER_DRAIN = false; static_assert(ACT == 0 || ACT == 1, "EpiBf16: ACT is 0 (none) or 1 (gelu_pk)");
    bf16_t* O; int ldc; const float* bias; int split_cols; size_t split_stride; float scale0;
    __device__ __forceinline__ void operator()(const f32x4 (&acc)[2][2][4][2], const Unit& u, int wr, int wc, int fr, int fq) const {
        const int row0 = u.pm * BM + wr * 64 + fr; int colt = u.pn * BM; bf16_t* base = O;
        float sc = 1.f; if (split_cols) { const int t = colt / split_cols; base += (size_t)t * split_stride; colt -= t * split_cols; if (t == 0) sc = scale0; }
        const int col0 = colt + wc * 32 + 8 * fq, bcol0 = u.pn * BM + wc * 32 + 8 * fq;
        f32x4 bv[2][2];
#pragma unroll
        for (int bj = 0; bj < 2; ++bj)
#pragma unroll
            for (int n = 0; n < 2; ++n) bv[bj][n] = bias ? *(const f32x4*)(bias + bcol0 + bj * HALF + 4 * n) : (f32x4){0.f, 0.f, 0.f, 0.f};
#pragma unroll
        for (int ai = 0; ai < 2; ++ai)
#pragma unroll
            for (int m = 0; m < 4; ++m) { bf16_t* rowp = base + (size_t)(row0 + ai * HALF + m * 16) * ldc + col0;
#pragma unroll
                for (int bj = 0; bj < 2; ++bj) { f32x4 v0 = acc[ai][bj][m][0] + bv[bj][0], v1 = acc[ai][bj][m][1] + bv[bj][1];
                    if (ACT == 1) { f32x2 a = gelu_pk((f32x2){v0[0], v0[1]}), b = gelu_pk((f32x2){v0[2], v0[3]}), c = gelu_pk((f32x2){v1[0], v1[1]}), d = gelu_pk((f32x2){v1[2], v1[3]});
                        v0 = (f32x4){a.x, a.y, b.x, b.y}; v1 = (f32x4){c.x, c.y, d.x, d.y}; }
                    v0 = v0 * sc; v1 = v1 * sc; u32x4 w; w.x = cvt_pk_bf16(v0[0], v0[1]); w.y = cvt_pk_bf16(v0[2], v0[3]); w.z = cvt_pk_bf16(v1[0], v1[1]); w.w = cvt_pk_bf16(v1[2], v1[3]);
                    *(u32x4*)(rowp + bj * HALF) = w; } }
    }
};
__device__ __forceinline__ float silu_f(float x) { return x / (1.0f + __expf(-x)); }
struct EpiSwiglu {
    static constexpr bool PERM = true, AFTER_DRAIN = false;
    bf16_t* O; int ldc;
    __device__ __forceinline__ void operator()(const f32x4 (&acc)[2][2][4][2], const Unit& u, int wr, int wc, int fr, int fq) const {
        const int row0 = u.pm * BM + wr * 64 + fr; const int col0 = u.pn * HALF + wc * 32 + 8 * fq;
#pragma unroll
        for (int ai = 0; ai < 2; ++ai)
#pragma unroll
            for (int m = 0; m < 4; ++m) { bf16_t* rowp = O + (size_t)(row0 + ai * HALF + m * 16) * ldc + col0;
                const f32x4 g0 = acc[ai][0][m][0], g1 = acc[ai][0][m][1], u0 = acc[ai][1][m][0], u1 = acc[ai][1][m][1];
                u32x4 w;
                w.x = cvt_pk_bf16(silu_f(g0[0]) * u0[0], silu_f(g0[1]) * u0[1]); w.y = cvt_pk_bf16(silu_f(g0[2]) * u0[2], silu_f(g0[3]) * u0[3]);
                w.z = cvt_pk_bf16(silu_f(g1[0]) * u1[0], silu_f(g1[1]) * u1[1]); w.w = cvt_pk_bf16(silu_f(g1[2]) * u1[2], silu_f(g1[3]) * u1[3]);
                *(u32x4*)rowp = w; }
    }
};
struct EpiRes {
    static constexpr bool PERM = false, AFTER_DRAIN = false;
    const float* res; float* out; int ldc; float alpha;
    __device__ __forceinline__ void operator()(const f32x4 (&acc)[2][2][4][2], const Unit& u, int wr, int wc, int fr, int fq) const {
        const int row0 = u.pm * BM + wr * 64 + fr, col0 = u.pn * BM + wc * 32 + 4 * fq;
#pragma unroll
        for (int ai = 0; ai < 2; ++ai)
#pragma unroll
            for (int m = 0; m < 4; ++m) { const size_t off = (size_t)(row0 + ai * HALF + m * 16) * ldc + col0;
#pragma unroll
                for (int bj = 0; bj < 2; ++bj)
#pragma unroll
                    for (int n = 0; n < 2; ++n) { const f32x4 x = *(const f32x4*)(res + off + bj * HALF + n * 16);
                        *(f32x4*)(out + off + bj * HALF + n * 16) = x * alpha + acc[ai][bj][m][n]; } }
    }
};
template <class Epi, class Sched, bool ALIGN_EPI = false, bool SP2 = false>
__device__ __forceinline__ void gemm_phase(PG8_LAS unsigned char* lds, const Gemm g, const Sched& S, const Epi& E) {
    int tid_l = threadIdx.x; asm volatile("" : "+v"(tid_l)); const int tid = tid_l, wid = __builtin_amdgcn_readfirstlane(tid >> 6), lane = tid & 63, wr = wid >> 2, wc = wid & 3, fr = lane & 15, fq = lane >> 4;
    const int K = g.K, nt = K / BK;
    unsigned voffA[2], voffB[2];
#pragma unroll
    for (int i = 0; i < 2; ++i) { int R, C; stage_rc(tid * 16 + i * 8192, R, C); const int Rb = Epi::PERM ? ((R & ~31) + perm32(R & 31)) : R;
        voffA[i] = (unsigned)(R * K + C) * 2u; voffB[i] = (unsigned)(Rb * K + C) * 2u; }
    const size_t kstep = (size_t)(BK * 2);
    const size_t hstep = (size_t)HALF * K * 2;
    const size_t tstep = 2 * hstep;
    const unsigned ldsw = (unsigned)wid * 1024u;
    const int aoff = lds_byte(wr * 64 + fr, fq * 8), boff = lds_byte(wc * 32 + fr, fq * 8);
#define PG8_SA(b, h) (((b) * 2 + (h)) * HTB)
#define PG8_SB(b, h) ((4 + (b) * 2 + (h)) * HTB)
#define PG8_STAGE(bufoff, gbase, voff) do { _Pragma("unroll") for (int _i = 0; _i < 2; ++_i) \
        __builtin_amdgcn_global_load_lds((const unsigned*)((const char*)(gbase) + (voff)[_i]), (PG8_LAS unsigned*)(lds + (bufoff) + ldsw + _i * 8192), 16, 0, 0); } while (0)
#define PG8_LDA(dst, b, h) do { _Pragma("unroll") for (int m = 0; m < 4; ++m) _Pragma("unroll") for (int k = 0; k < 2; ++k) dst[m][k] = *(const PG8_LAS bf16x8*)(lds + PG8_SA(b, h) + aoff + m * 2048 + k * 1024); } while (0)
#define PG8_LDB(dst, b, h) do { _Pragma("unroll") for (int n = 0; n < 2; ++n) _Pragma("unroll") for (int k = 0; k < 2; ++k) dst[n][k] = *(const PG8_LAS bf16x8*)(lds + PG8_SB(b, h) + boff + n * 2048 + k * 1024); } while (0)
#define PG8_MMA(ai, bj, At, Bt) do { __builtin_amdgcn_s_setprio(1); _Pragma("unroll") for (int m = 0; m < 4; ++m) _Pragma("unroll") for (int n = 0; n < 2; ++n) _Pragma("unroll") for (int k = 0; k < 2; ++k) \
        acc[ai][bj][m][n] = __builtin_amdgcn_mfma_f32_16x16x32_bf16(Bt[n][k], At[m][k], acc[ai][bj][m][n], 0, 0, 0); __builtin_amdgcn_s_setprio(0); } while (0)
#define PG8_WAIT_V(n) asm volatile("s_waitcnt vmcnt(" #n ")" ::: "memory")
#define PG8_WAIT_L(n) asm volatile("s_waitcnt lgkmcnt(" #n ")" ::: "memory")
#define PG8_BAR __builtin_amdgcn_s_barrier()
#define PG8_SCHED __builtin_amdgcn_sched_barrier(0)
    Unit cur, nxt; int ui = 0;
    if (!S.next(0, cur)) return;
    f32x4 acc[2][2][4][2];
#pragma unroll
    for (int a = 0; a < 2; ++a)
#pragma unroll
        for (int b = 0; b < 2; ++b)
#pragma unroll
            for (int m = 0; m < 4; ++m)
#pragma unroll
                for (int n = 0; n < 2; ++n) acc[a][b][m][n] = (f32x4){0.f, 0.f, 0.f, 0.f};
    bf16x8 At[4][2], B0[2][2], B1[2][2];
    const char* cA = (const char*)g.A + (size_t)cur.pm * tstep; const char* cB = (const char*)g.Bt + (size_t)cur.pn * tstep;
    S.a_ready(cur);
    if constexpr (SP2) {
        PG8_STAGE(PG8_SB(0, 0), cB, voffB); PG8_STAGE(PG8_SB(0, 1), cB + hstep, voffB); PG8_STAGE(PG8_SA(0, 0), cA, voffA); PG8_STAGE(PG8_SA(0, 1), cA + hstep, voffA);
        if (wr == 1) PG8_BAR;
        PG8_WAIT_V(2); PG8_BAR;
        PG8_STAGE(PG8_SB(1, 0), cB + kstep, voffB); PG8_STAGE(PG8_SA(1, 0), cA + kstep, voffA); PG8_STAGE(PG8_SB(1, 1), cB + hstep + kstep, voffB);
        PG8_WAIT_V(6); PG8_BAR;
    } else {
        PG8_STAGE(PG8_SB(0, 0), cB, voffB); PG8_STAGE(PG8_SA(0, 0), cA, voffA); PG8_STAGE(PG8_SB(0, 1), cB + hstep, voffB); PG8_STAGE(PG8_SA(0, 1), cA + hstep, voffA);
        if (wr == 1) PG8_BAR;
        PG8_WAIT_V(4); PG8_BAR;
        PG8_STAGE(PG8_SB(1, 0), cB + kstep, voffB); PG8_STAGE(PG8_SA(1, 0), cA + kstep, voffA); PG8_STAGE(PG8_SB(1, 1), cB + hstep + kstep, voffB);
        PG8_WAIT_V(6); PG8_BAR;
    }
    for (;;) {
        const bool has_next = S.next(ui + 1, nxt);
        const char* nA = has_next ? (const char*)g.A + (size_t)nxt.pm * tstep : cA; const char* nB = has_next ? (const char*)g.Bt + (size_t)nxt.pn * tstep : cB;
        for (int t = 0; t < nt; t += 2) {
            const bool last = (t == nt - 2);
            const char* a1 = cA + (size_t)(t + 1) * kstep;
            const char* a2 = last ? nA : cA + (size_t)(t + 2) * kstep; const char* b2 = last ? nB : cB + (size_t)(t + 2) * kstep;
            const char* a3 = a2 + kstep; const char* b3 = b2 + kstep;
            if (last && has_next) S.a_ready(nxt);
            if constexpr (SP2) {
            PG8_LDB(B0, 0, 0); PG8_LDB(B1, 0, 1); PG8_SCHED; PG8_LDA(At, 0, 0); PG8_STAGE(PG8_SA(1, 1), a1 + hstep, voffA);
            PG8_WAIT_V(8); PG8_WAIT_L(0); PG8_BAR; PG8_MMA(0, 0, At, B0); PG8_MMA(0, 1, At, B1); PG8_BAR; PG8_SCHED;
            PG8_LDA(At, 0, 1); PG8_STAGE(PG8_SB(0, 0), b2, voffB); PG8_STAGE(PG8_SB(0, 1), b2 + hstep, voffB); PG8_STAGE(PG8_SA(0, 0), a2, voffA);
            PG8_WAIT_V(8); PG8_WAIT_L(0); PG8_BAR; PG8_MMA(1, 0, At, B0); PG8_MMA(1, 1, At, B1); PG8_BAR; PG8_SCHED;
            PG8_LDB(B0, 1, 0); PG8_LDB(B1, 1, 1); PG8_SCHED; PG8_LDA(At, 1, 0); PG8_STAGE(PG8_SA(0, 1), a2 + hstep, voffA);
            PG8_WAIT_V(8); PG8_WAIT_L(0); PG8_BAR; PG8_MMA(0, 0, At, B0); PG8_MMA(0, 1, At, B1); PG8_BAR; PG8_SCHED;
            PG8_LDA(At, 1, 1); PG8_STAGE(PG8_SB(1, 0), b3, voffB); PG8_STAGE(PG8_SB(1, 1), b3 + hstep, voffB); PG8_STAGE(PG8_SA(1, 0), a3, voffA);
            PG8_WAIT_V(8); PG8_WAIT_L(0); PG8_BAR; PG8_MMA(1, 0, At, B0); PG8_MMA(1, 1, At, B1); PG8_BAR; PG8_SCHED;
            } else {
            PG8_LDB(B0, 0, 0); PG8_SCHED; PG8_LDA(At, 0, 0); PG8_STAGE(PG8_SA(1, 1), a1 + hstep, voffA);
            PG8_WAIT_L(8); PG8_BAR; PG8_WAIT_L(0); PG8_MMA(0, 0, At, B0); PG8_BAR; PG8_SCHED;
            PG8_LDB(B1, 0, 1); PG8_STAGE(PG8_SB(0, 0), b2, voffB);
            PG8_BAR; PG8_WAIT_L(0); PG8_MMA(0, 1, At, B1); PG8_BAR;
            PG8_LDA(At, 0, 1); PG8_STAGE(PG8_SA(0, 0), a2, voffA);
            PG8_BAR; PG8_WAIT_L(0); PG8_MMA(1, 0, At, B0); PG8_BAR; PG8_SCHED;
            PG8_STAGE(PG8_SB(0, 1), b2 + hstep, voffB);
            PG8_WAIT_V(6); PG8_BAR; PG8_MMA(1, 1, At, B1); PG8_BAR;
            PG8_LDB(B0, 1, 0); PG8_SCHED; PG8_LDA(At, 1, 0); PG8_STAGE(PG8_SA(0, 1), a2 + hstep, voffA);
            PG8_WAIT_L(8); PG8_BAR; PG8_WAIT_L(0); PG8_MMA(0, 0, At, B0); PG8_BAR; PG8_SCHED;
            PG8_LDB(B1, 1, 1); PG8_STAGE(PG8_SB(1, 0), b3, voffB);
            PG8_BAR; PG8_WAIT_L(0); PG8_MMA(0, 1, At, B1); PG8_BAR;
            PG8_LDA(At, 1, 1); PG8_STAGE(PG8_SA(1, 0), a3, voffA);
            PG8_BAR; PG8_WAIT_L(0); PG8_MMA(1, 0, At, B0); PG8_BAR; PG8_SCHED;
            PG8_STAGE(PG8_SB(1, 1), b3 + hstep, voffB);
            PG8_WAIT_V(6); PG8_BAR; PG8_MMA(1, 1, At, B1); PG8_BAR;
            }
        }
        if constexpr (ALIGN_EPI) { if (wr == 0) PG8_BAR; }
        if constexpr (!Epi::AFTER_DRAIN) { E(acc, cur, wr, wc, fr, fq); S.done(cur); }
        if (!has_next) break;
#pragma unroll
        for (int a = 0; a < 2; ++a)
#pragma unroll
            for (int b = 0; b < 2; ++b)
#pragma unroll
                for (int m = 0; m < 4; ++m)
#pragma unroll
                    for (int n = 0; n < 2; ++n) acc[a][b][m][n] = (f32x4){0.f, 0.f, 0.f, 0.f};
        cur = nxt; cA = nA; cB = nB; ++ui;
        if constexpr (ALIGN_EPI) { if (wr == 1) PG8_BAR; }
    }
    PG8_WAIT_V(0);
    if constexpr (!ALIGN_EPI) { if (wr == 0) PG8_BAR; }
    PG8_BAR;
    if constexpr (Epi::AFTER_DRAIN) { E.fused(acc, cur, wr, wc, fr, fq, lds, wid, lane); S.done(cur); }
#undef PG8_SA
#undef PG8_SB
#undef PG8_STAGE
#undef PG8_LDA
#undef PG8_LDB
#undef PG8_MMA
#undef PG8_WAIT_V
#undef PG8_WAIT_L
#undef PG8_BAR
#undef PG8_SCHED
}
}

namespace cg = cooperative_groups;
namespace mk {
using pg8::bf16_t; using pg8::bf16x8; using pg8::f32x4; using pg8::u32x4;
typedef unsigned u32x2 __attribute__((ext_vector_type(2)));
typedef short bf16x4 __attribute__((ext_vector_type(4)));
#define LAS __attribute__((address_space(3)))

constexpr int BATCH = 2, SEQ = 16384, DM = 1024, M = BATCH * SEQ, FFH = 2816;
constexpr float ALPHA = 1.681792830507429f, EPS = 1e-5f, LOG2E = 1.4426950408889634f;
constexpr size_t MiB = 1u << 20;
constexpr size_t WS_W = 1 * MiB, WS_XN = 33 * MiB, WS_PROJ = 97 * MiB, WS_MIX = 289 * MiB, WS_ST = 417 * MiB, WS_DEC = 481 * MiB, WS_TAB = 481 * MiB + 65536;
constexpr size_t WO_IN = 0, WO_OUT = (size_t)5888 * 1024, WO_GU = WO_OUT + (size_t)1024 * 2048, WO_D = WO_GU + (size_t)5632 * 1024;
constexpr int LDS_BYTES = 147456;

__device__ __forceinline__ float bflo(unsigned w) { return __uint_as_float(w << 16); }
__device__ __forceinline__ float bfhi(unsigned w) { return __uint_as_float(w & 0xffff0000u); }
__device__ __forceinline__ float bf2f(bf16_t v) { return __uint_as_float(((unsigned)v) << 16); }
__device__ __forceinline__ unsigned f2bf(float f) { unsigned u = __float_as_uint(f); return (u + 0x7fffu + ((u >> 16) & 1u)) >> 16; }
__device__ __forceinline__ unsigned pk2(float lo, float hi) { return f2bf(lo) | (f2bf(hi) << 16); }
__device__ __forceinline__ void unpack8(const u32x4 v, float* o) { o[0] = bflo(v.x); o[1] = bfhi(v.x); o[2] = bflo(v.y); o[3] = bfhi(v.y); o[4] = bflo(v.z); o[5] = bfhi(v.z); o[6] = bflo(v.w); o[7] = bfhi(v.w); }
__device__ __forceinline__ u32x4 pack8(const float* o) { u32x4 v; v.x = pk2(o[0], o[1]); v.y = pk2(o[2], o[3]); v.z = pk2(o[4], o[5]); v.w = pk2(o[6], o[7]); return v; }
__device__ __forceinline__ float silu(float x) { return x / (1.0f + __expf(-x)); }
__device__ __forceinline__ float wave_sum(float v) {
#pragma unroll
    for (int o = 1; o < 64; o <<= 1) v += __shfl_xor(v, o);
    return v;
}
__device__ __forceinline__ float wave_scan_incl(float v, int lane) {
#pragma unroll
    for (int o = 1; o < 64; o <<= 1) { const float t = __shfl_up(v, o); if (lane >= o) v += t; }
    return v;
}
__device__ __forceinline__ f32x4 mfma16(bf16x8 a, bf16x8 b, f32x4 c) { return __builtin_amdgcn_mfma_f32_16x16x32_bf16(a, b, c, 0, 0, 0); }
__device__ __forceinline__ bf16x8 cat44(bf16x4 a, bf16x4 b) { return __builtin_shufflevector(a, b, 0, 1, 2, 3, 4, 5, 6, 7); }
__device__ __forceinline__ bf16x8 packf8(f32x4 a, f32x4 b) { u32x4 v; v.x = pk2(a[0], a[1]); v.y = pk2(a[2], a[3]); v.z = pk2(b[0], b[1]); v.w = pk2(b[2], b[3]); return __builtin_bit_cast(bf16x8, v); }
__device__ __forceinline__ void sincos_ang(float ang, float& s, float& c) {
    double t = (double)ang * 0.15915494309189535; t -= rint(t); const float f = (float)t;
    s = __builtin_amdgcn_sinf(f); c = __builtin_amdgcn_cosf(f);
}
__device__ __forceinline__ float log2gamma(int h) { return h == 0 ? -0.04580368961312479f : h == 1 ? -0.02272007650008353f : h == 2 ? -0.011315313227834146f : -0.005646563141142063f; }
__device__ __forceinline__ float softplus(float x) { return x > 20.f ? x : log1pf(__expf(x)); }

#define LAUNDER_V(x) asm volatile("" : "+v"(x))
#define LAUNDER_S(x) asm volatile("" : "+s"(x))
struct Params { const float* in[25]; float* out; unsigned char* ws; };
constexpr int PTR_OFF = LDS_BYTES - 512;
__device__ __forceinline__ unsigned long long ldq(LAS unsigned char* lds, int i) {
    volatile LAS unsigned long long* t = (volatile LAS unsigned long long*)(lds + PTR_OFF); const unsigned long long v = t[i];
    const unsigned lo = __builtin_amdgcn_readfirstlane((unsigned)v), hi = __builtin_amdgcn_readfirstlane((unsigned)(v >> 32));
    return ((unsigned long long)hi << 32) | lo;
}
__device__ __forceinline__ const float* ldin(LAS unsigned char* lds, int i) { return (const float*)ldq(lds, i); }
__device__ __forceinline__ unsigned char* ldws(LAS unsigned char* lds) { return (unsigned char*)ldq(lds, 26); }
__device__ __forceinline__ float* ldout(LAS unsigned char* lds) { return (float*)ldq(lds, 25); }

#define XB_TMO      128
#define XB_XCNT(j)  (256  + 64 * (j))
#define XB_XSUB(j)  (1280 + 64 * (j))
#define XB_XGEN(j)  (2304 + 64 * (j))
#define XB_TOP      3328
#define XB_TOPGEN   3392
#define XCD_BAR_WORDS 3456
#define XB_SPIN_CAP (1u << 18)

__device__ __forceinline__ unsigned xb_ld(unsigned* p)              { return __hip_atomic_load(p, __ATOMIC_RELAXED, __HIP_MEMORY_SCOPE_AGENT); }
__device__ __forceinline__ unsigned xb_add(unsigned* p, unsigned v) { return __hip_atomic_fetch_add(p, v, __ATOMIC_RELAXED, __HIP_MEMORY_SCOPE_AGENT); }
__device__ __forceinline__ unsigned xb_xcc_id() { return (unsigned)__builtin_amdgcn_s_getreg((3 << 11) | 20) & 0xFu; }
#define XB_SPIN(cond, bar) do { unsigned _sp = 0; while (cond) { __builtin_amdgcn_s_sleep(1); \
    if ((++_sp & 255u) == 0u) { if (xb_ld(&(bar)[XB_TMO])) break; if (_sp > XB_SPIN_CAP) { atomicAdd(&(bar)[XB_TMO], 1u); break; } } } } while (0)

struct XcdBarrier {
    unsigned* bar; unsigned x;
    volatile LAS unsigned* st;
};

__device__ __forceinline__ XcdBarrier xcd_barrier_post(unsigned* bar, volatile LAS unsigned* st) {
    XcdBarrier b; b.bar = bar; b.x = xb_xcc_id(); b.st = st;
    if (threadIdx.x == 0) (void)xb_add(&bar[XB_XCNT(b.x)], 1u);
    return b;
}
__device__ __forceinline__ void xcd_barrier_complete(unsigned* bar, unsigned x, unsigned& nloc, unsigned& nx) {
    const unsigned G = gridDim.x * gridDim.y * gridDim.z;
    unsigned sum, cnt, mine, sp = 0u;
    for (;;) {
        sum = 0u; cnt = 0u; mine = 0u;
#pragma unroll
        for (unsigned j = 0; j < 16; ++j) { const unsigned c = xb_ld(&bar[XB_XCNT(j)]); sum += c; cnt += (c > 0u) ? 1u : 0u; mine = (j == x) ? c : mine; }
        if (sum == G) break;
        __builtin_amdgcn_s_sleep(1);
        if ((++sp & 255u) == 0u) { if (xb_ld(&bar[XB_TMO])) break; if (sp > XB_SPIN_CAP) { atomicAdd(&bar[XB_TMO], 1u); break; } }
    }
    nloc = mine > 0u ? mine : 1u; nx = cnt > 0u ? cnt : 1u;
}

__device__ __forceinline__ void xcd_barrier(const XcdBarrier& b) {
    asm volatile("s_waitcnt vmcnt(0)" ::: "memory");
    __syncthreads();
    if (threadIdx.x == 0) {
        unsigned* bar = b.bar;
        __builtin_amdgcn_s_waitcnt(0);
        unsigned nloc = b.st[0], nx = b.st[1];
        if (nloc == 0u) { xcd_barrier_complete(bar, b.x, nloc, nx); b.st[0] = nloc; b.st[1] = nx; }
        const unsigned old = xb_add(&bar[XB_XSUB(b.x)], 1u);
        const unsigned gen = old / nloc;
        if (old + 1u == (gen + 1u) * nloc) {
            __builtin_amdgcn_fence(__ATOMIC_RELEASE, "agent");
            asm volatile("s_waitcnt vmcnt(0)" ::: "memory");
            const unsigned og = xb_add(&bar[XB_TOP], 1u);
            const unsigned tg = og / nx;
            if (og + 1u == (tg + 1u) * nx) xb_add(&bar[XB_TOPGEN], 1u);
            else XB_SPIN(xb_ld(&bar[XB_TOPGEN]) == tg, bar);
            __builtin_amdgcn_fence(__ATOMIC_ACQUIRE, "agent");
            xb_add(&bar[XB_XGEN(b.x)], 1u);
            asm volatile("s_waitcnt vmcnt(0)" ::: "memory");
        } else {
            XB_SPIN(xb_ld(&bar[XB_XGEN(b.x)]) == gen, bar);
            __builtin_amdgcn_fence(__ATOMIC_ACQUIRE, "agent");
            asm volatile("s_waitcnt vmcnt(0)" ::: "memory");
        }
    }
    __syncthreads();
}


__device__ __forceinline__ void tr_item(const float* W, int N, int k0, int nsrc0, bf16_t* WT, int K, int drow0, LAS float* scr, int lane) {
#pragma unroll 8
    for (int i = 0; i < 32; ++i) { const int kk = 2 * i + (lane >> 5); scr[kk * 33 + (lane & 31)] = W[(size_t)(k0 + kk) * N + nsrc0 + (lane & 31)]; }
    asm volatile("s_waitcnt lgkmcnt(0)" ::: "memory");
    const int c = lane & 7;
#pragma unroll
    for (int j = 0; j < 4; ++j) { const int n = (lane >> 3) + 8 * j; const LAS float* s = scr + (8 * c) * 33 + n;
        u32x4 o; o.x = pk2(s[0 * 33], s[1 * 33]); o.y = pk2(s[2 * 33], s[3 * 33]); o.z = pk2(s[4 * 33], s[5 * 33]); o.w = pk2(s[6 * 33], s[7 * 33]);
        *(u32x4*)(WT + (size_t)(drow0 + n) * K + k0 + 8 * c) = o; }
    asm volatile("s_waitcnt lgkmcnt(0)" ::: "memory");
}
__device__ __forceinline__ void convert_layer(int L, LAS unsigned char* lds, int gw, int NGW, int lane, int wave, int gtid, int nthr) {
    LAUNDER_V(lane); LAUNDER_S(wave); LAUNDER_S(gw); LAUNDER_V(gtid);
    bf16_t* Wb = (bf16_t*)(ldws(lds) + WS_W);
    LAS float* scr = (LAS float*)(lds + wave * 16384);
    const int e = L >> 1; const bool odd = (L & 1) != 0;
    const int cIN = odd ? (16 * 80 + 16 * 96) : 16 * 56, cOUT = odd ? 32 * 32 : 16 * 32, cG = 16 * 88, cD = 44 * 32;
    const int total = cIN + cOUT + 2 * cG + cD;
    for (int it = gw; it < total; it += NGW) {
        int r = it; const float* W; int N, k0, nsrc0, K, drow0; bf16_t* WT;
        if (r < cIN) {
            WT = Wb + WO_IN; K = 1024;
            if (!odd) { const int nb = r % 56, kb = r / 56; W = ldin(lds, 8) + (size_t)e * 1024 * 1792; N = 1792; k0 = kb * 64; nsrc0 = nb * 32; drow0 = nb * 32; }
            else if (r < 1280) { const int nb = r % 80, kb = r / 80; W = ldin(lds, 15) + (size_t)e * 1024 * 5648; N = 5648; k0 = kb * 64; nsrc0 = nb * 32; drow0 = nb * 32; }
            else { const int r2 = r - 1280; const int nb = r2 % 96, kb = r2 / 96; W = ldin(lds, 15) + (size_t)e * 1024 * 5648; N = 5648; k0 = kb * 64; nsrc0 = 2576 + nb * 32; drow0 = 2816 + nb * 32; }
        } else if ((r -= cIN) < cOUT) {
            WT = Wb + WO_OUT; const int nb = r % 32, kb = r / 32; N = 1024; k0 = kb * 64; nsrc0 = nb * 32; drow0 = nb * 32;
            if (!odd) { W = ldin(lds, 14) + (size_t)e * 1024 * 1024; K = 1024; } else { W = ldin(lds, 24) + (size_t)e * 2048 * 1024; K = 2048; }
        } else if ((r -= cOUT) < 2 * cG) {
            const int up = r >= cG ? 1 : 0; if (up) r -= cG;
            WT = Wb + WO_GU; K = 1024; const int nb = r % 88, kb = r / 88; const int j0 = nb * 32;
            W = ldin(lds, up ? 6 : 5) + (size_t)L * 1024 * 2816; N = 2816; k0 = kb * 64; nsrc0 = j0; drow0 = (j0 >> 7) * 256 + (j0 & 127) + up * 128;
        } else {
            r -= 2 * cG; WT = Wb + WO_D; K = 2816; const int nb = r % 32, kb = r / 32;
            W = ldin(lds, 7) + (size_t)L * 2816 * 1024; N = 1024; k0 = kb * 64; nsrc0 = nb * 32; drow0 = nb * 32;
        }
        tr_item(W, N, k0, nsrc0, WT, K, drow0, scr, lane);
    }
    if (odd) {
        const float* W = ldin(lds, 15) + (size_t)e * 1024 * 5648; bf16_t* WT = Wb + WO_IN;
        for (int idx = gtid; idx < 16 * 1024; idx += nthr) { const int n = idx >> 10, k = idx & 1023; WT[(size_t)(2560 + n) * 1024 + k] = (bf16_t)f2bf(W[(size_t)k * 5648 + 2560 + n]); }
        unsigned* z = (unsigned*)(WT + (size_t)2576 * 1024);
        for (int idx = gtid; idx < 240 * 512; idx += nthr) z[idx] = 0u;
    }
}

__device__ __forceinline__ void ln_phase(float* X, bf16_t* XN, const float* g, const float* b, int gw, int NGW, int lane) {
    LAUNDER_V(lane); LAUNDER_S(gw);
    for (int m = gw; m < M; m += NGW) {
        float* xr = X + (size_t)m * DM + lane * 4;
        f32x4 v[4]; float s = 0.f;
#pragma unroll
        for (int j = 0; j < 4; ++j) { v[j] = *(const f32x4*)(xr + j * 256); s += (v[j][0] + v[j][1]) + (v[j][2] + v[j][3]); }
        const float mean = wave_sum(s) * (1.f / DM); float q = 0.f;
#pragma unroll
        for (int j = 0; j < 4; ++j) { v[j] = v[j] - mean; q += (v[j][0] * v[j][0] + v[j][1] * v[j][1]) + (v[j][2] * v[j][2] + v[j][3] * v[j][3]); }
        const float rstd = 1.0f / sqrtf(wave_sum(q) * (1.f / DM) + EPS);
#pragma unroll
        for (int j = 0; j < 4; ++j) { const f32x4 gg = *(const f32x4*)(g + j * 256 + lane * 4), bb = *(const f32x4*)(b + j * 256 + lane * 4);
            const f32x4 y = v[j] * rstd * gg + bb; *(f32x4*)(xr + j * 256) = y;
            u32x2 w; w.x = pk2(y[0], y[1]); w.y = pk2(y[2], y[3]); *(u32x2*)(XN + (size_t)m * DM + j * 256 + lane * 4) = w; }
    }
}

__device__ __forceinline__ void rope16(u32x4& a, u32x4& c, float pos, const float* inv) {
    float x1[8], x2[8], o1[8], o2[8]; unpack8(a, x1); unpack8(c, x2);
#pragma unroll
    for (int e = 0; e < 8; ++e) { float s, co; sincos_ang(pos * inv[e], s, co); o1[e] = x1[e] * co - x2[e] * s; o2[e] = x2[e] * co + x1[e] * s; }
    a = pack8(o1); c = pack8(o2);
}
__device__ __forceinline__ void attn_unit(LAS unsigned char* lds, const bf16_t* PR, bf16_t* MIX, const float* sinks, const float* inv_att, int b, int n, int j, int tid, int lane, int wave) {
    LAUNDER_V(tid); LAUNDER_V(lane); LAUNDER_S(wave);
    constexpr int QS = 72, VS = 264;
    LAS bf16_t* Qs = (LAS bf16_t*)lds;
    LAS bf16_t* Ks = (LAS bf16_t*)(lds + 73728);
    LAS bf16_t* Vt = (LAS bf16_t*)(lds + 73728 + 36864);
    const size_t R0 = (size_t)b * SEQ + (size_t)n * 128;
#pragma unroll 1
    for (int it = 0; it < 4; ++it) { const int idx = tid + it * 512; const int cp = idx & 3, i = (idx >> 2) & 127, g = idx >> 9;
        const bf16_t* src = PR + (R0 + i) * 1792 + (j * 4 + g) * 64 + cp * 16;
        u32x4 a = *(const u32x4*)src, c = *(const u32x4*)(src + 8);
        if (cp == 0) rope16(a, c, (float)(n * 128 + i), inv_att);
        LAS bf16_t* dst = Qs + (g * 128 + i) * QS + cp * 16; *(LAS u32x4*)dst = a; *(LAS u32x4*)(dst + 8) = c; }
#pragma unroll 1
    for (int it = 0; it < 2; ++it) { const int idx = tid + it * 512; const int cp = idx & 3, jj = idx >> 2;
        u32x4 a = (u32x4){0u, 0u, 0u, 0u}, c = a;
        if (n > 0 || jj >= 128) { const bf16_t* src = PR + (R0 + jj - 128) * 1792 + 512 + j * 64 + cp * 16; a = *(const u32x4*)src; c = *(const u32x4*)(src + 8);
            if (cp == 0) rope16(a, c, (float)(n * 128 - 128 + jj), inv_att); }
        LAS bf16_t* dst = Ks + jj * QS + cp * 16; *(LAS u32x4*)dst = a; *(LAS u32x4*)(dst + 8) = c; }
#pragma unroll 1
    for (int it = 0; it < 4; ++it) { const int idx = tid + it * 512; const int jj = idx & 255, c8 = idx >> 8;
        u32x4 a = (u32x4){0u, 0u, 0u, 0u};
        if (n > 0 || jj >= 128) a = *(const u32x4*)(PR + (R0 + jj - 128) * 1792 + 640 + j * 64 + c8 * 8);
        LAS bf16_t* dst = Vt + (c8 * 8) * VS + jj;
        dst[0 * VS] = (bf16_t)(a.x & 0xffffu); dst[1 * VS] = (bf16_t)(a.x >> 16); dst[2 * VS] = (bf16_t)(a.y & 0xffffu); dst[3 * VS] = (bf16_t)(a.y >> 16);
        dst[4 * VS] = (bf16_t)(a.z & 0xffffu); dst[5 * VS] = (bf16_t)(a.z >> 16); dst[6 * VS] = (bf16_t)(a.w & 0xffffu); dst[7 * VS] = (bf16_t)(a.w >> 16); }
    __syncthreads();
    const int fr = lane & 15, fq = lane >> 4; const int g = wave >> 1, half = (wave & 1) * 64;
    const float sink = sinks[j * 4 + g] * LOG2E; const float SC = 0.125f * LOG2E;
#pragma unroll 1
    for (int qt = 0; qt < 4; ++qt) {
        const int i0 = half + qt * 16, klo = i0 & ~31, i = i0 + fr;
        const LAS bf16_t* qp = Qs + (g * 128 + i0 + fr) * QS + fq * 8;
        const bf16x8 qf0 = *(const LAS bf16x8*)qp, qf1 = *(const LAS bf16x8*)(qp + 32);
        f32x4 s[10];
#pragma unroll
        for (int t = 0; t < 10; ++t) { const LAS bf16_t* kp = Ks + (klo + t * 16 + fr) * QS + fq * 8;
            const bf16x8 k0 = *(const LAS bf16x8*)kp, k1 = *(const LAS bf16x8*)(kp + 32);
            s[t] = mfma16(k0, qf0, (f32x4){0.f, 0.f, 0.f, 0.f}); s[t] = mfma16(k1, qf1, s[t]); }
        float mx = sink;
#pragma unroll
        for (int t = 0; t < 10; ++t)
#pragma unroll
            for (int r = 0; r < 4; ++r) { const int jj = klo + t * 16 + fq * 4 + r; const bool valid = (jj > i) && (jj <= i + 128) && (n > 0 || jj >= 128);
                const float v = valid ? s[t][r] * SC : -INFINITY; s[t][r] = v; mx = fmaxf(mx, v); }
        mx = fmaxf(mx, __shfl_xor(mx, 16)); mx = fmaxf(mx, __shfl_xor(mx, 32));
        float l = 0.f;
#pragma unroll
        for (int t = 0; t < 10; ++t)
#pragma unroll
            for (int r = 0; r < 4; ++r) { const float p = exp2f(s[t][r] - mx); s[t][r] = p; l += p; }
        l += __shfl_xor(l, 16); l += __shfl_xor(l, 32); l += exp2f(sink - mx);
        const float linv = 1.0f / l;
        bf16x8 pf[5];
#pragma unroll
        for (int ks = 0; ks < 5; ++ks) pf[ks] = packf8(s[2 * ks], s[2 * ks + 1]);
#pragma unroll
        for (int nt = 0; nt < 4; ++nt) { f32x4 o = (f32x4){0.f, 0.f, 0.f, 0.f};
#pragma unroll
            for (int ks = 0; ks < 5; ++ks) { const LAS bf16_t* vp = Vt + (nt * 16 + fr) * VS + klo + ks * 32 + fq * 4;
                const bf16x8 vf = cat44(*(const LAS bf16x4*)vp, *(const LAS bf16x4*)(vp + 16)); o = mfma16(vf, pf[ks], o); }
            u32x2 w; w.x = pk2(o[0] * linv, o[1] * linv); w.y = pk2(o[2] * linv, o[3] * linv);
            *(u32x2*)(MIX + (R0 + i0 + fr) * 1024 + (j * 4 + g) * 64 + nt * 16 + fq * 4) = w; }
    }
    __syncthreads();
}
__device__ __forceinline__ void conv_unit(LAS unsigned char* lds, const bf16_t* PR, bf16_t* MIX, const float* dw_w, const float* dw_b, const float* cn_g, const float* cn_b, int b, int tb, int tid, int lane, int wave) {
    LAUNDER_V(tid); LAUNDER_V(lane); LAUNDER_S(wave);
    LAS float* hs = (LAS float*)lds;
    const int t0 = tb * 32; const size_t Rb = (size_t)b * SEQ;
#pragma unroll 1
    for (int idx = tid; idx < 62 * 64; idx += 512) { const int c8 = idx & 63, r = idx >> 6; const int t = t0 - 30 + r;
        float h[8];
#pragma unroll
        for (int e = 0; e < 8; ++e) h[e] = 0.f;
        if (t >= 0) { const bf16_t* src = PR + (Rb + t) * 1792 + 768 + c8 * 8; const u32x4 av = *(const u32x4*)src, gv = *(const u32x4*)(src + 512);
            float a[8], gt[8]; unpack8(av, a); unpack8(gv, gt);
#pragma unroll
            for (int e = 0; e < 8; ++e) h[e] = a[e] / (1.0f + __expf(-gt[e])); }
        LAS float* dst = hs + r * 512 + c8 * 8; *(LAS f32x4*)dst = (f32x4){h[0], h[1], h[2], h[3]}; *(LAS f32x4*)(dst + 4) = (f32x4){h[4], h[5], h[6], h[7]}; }
    __syncthreads();
    { const int c = tid; float w[31];
#pragma unroll
        for (int k = 0; k < 31; ++k) w[k] = dw_w[k * 512 + c];
        const float bias = dw_b[c];
#pragma unroll 1
        for (int tt = 0; tt < 32; ++tt) { float acc = bias;
#pragma unroll
            for (int k = 0; k < 31; ++k) acc += w[k] * hs[(tt + k) * 512 + c];
            hs[tt * 512 + c] = acc; } }
    __syncthreads();
#pragma unroll 1
    for (int q = 0; q < 4; ++q) { const int tt = wave * 4 + q;
        const f32x4 v0 = *(const LAS f32x4*)(hs + tt * 512 + lane * 8), v1 = *(const LAS f32x4*)(hs + tt * 512 + lane * 8 + 4);
        float s = (v0[0] + v0[1]) + (v0[2] + v0[3]) + (v1[0] + v1[1]) + (v1[2] + v1[3]);
        const float mean = wave_sum(s) * (1.f / 512.f);
        const f32x4 d0 = v0 - mean, d1 = v1 - mean;
        float qv = (d0[0] * d0[0] + d0[1] * d0[1]) + (d0[2] * d0[2] + d0[3] * d0[3]) + (d1[0] * d1[0] + d1[1] * d1[1]) + (d1[2] * d1[2] + d1[3] * d1[3]);
        const float rstd = 1.0f / sqrtf(wave_sum(qv) * (1.f / 512.f) + EPS);
        const f32x4 g0 = *(const f32x4*)(cn_g + lane * 8), g1 = *(const f32x4*)(cn_g + lane * 8 + 4), b0 = *(const f32x4*)(cn_b + lane * 8), b1 = *(const f32x4*)(cn_b + lane * 8 + 4);
        const f32x4 y0 = d0 * rstd * g0 + b0, y1 = d1 * rstd * g1 + b1;
        u32x4 w; w.x = pk2(silu(y0[0]), silu(y0[1])); w.y = pk2(silu(y0[2]), silu(y0[3])); w.z = pk2(silu(y1[0]), silu(y1[1])); w.w = pk2(silu(y1[2]), silu(y1[3]));
        *(u32x4*)(MIX + (Rb + t0 + tt) * 1024 + 512 + lane * 8) = w; }
    __syncthreads();
}

__device__ __forceinline__ void xbc_conv8(const bf16_t* PA, size_t grow, int t, int col, const float* cw, const float* cb, int cch, float* out) {
    const f32x4 b0 = *(const f32x4*)(cb + cch), b1 = *(const f32x4*)(cb + cch + 4);
    float acc[8] = {b0[0], b0[1], b0[2], b0[3], b1[0], b1[1], b1[2], b1[3]};
#pragma unroll
    for (int k = 0; k < 4; ++k) { const int tt = t - 3 + k;
        if (tt >= 0) { const u32x4 v = *(const u32x4*)(PA + (grow + k - 3) * 2816 + col); float x[8]; unpack8(v, x);
            const f32x4 w0 = *(const f32x4*)(cw + k * 1536 + cch), w1 = *(const f32x4*)(cw + k * 1536 + cch + 4);
            acc[0] += w0[0] * x[0]; acc[1] += w0[1] * x[1]; acc[2] += w0[2] * x[2]; acc[3] += w0[3] * x[3];
            acc[4] += w1[0] * x[4]; acc[5] += w1[1] * x[5]; acc[6] += w1[2] * x[6]; acc[7] += w1[3] * x[7]; } }
#pragma unroll
    for (int e = 0; e < 8; ++e) out[e] = silu(acc[e]);
}
__device__ __forceinline__ void ssd_local_unit(LAS unsigned char* lds, const bf16_t* PA, bf16_t* ST, float* DEC, const float* cw, const float* cb, const float* dt_bias, const float* a_log,
                                               int b, int c, int h, int tid, int lane, int wave) {
    LAUNDER_V(tid); LAUNDER_V(lane); LAUNDER_S(wave);
    constexpr int RS = 136;
    LAS bf16_t* XT = (LAS bf16_t*)lds;
    LAS bf16_t* BT = (LAS bf16_t*)(lds + 17408);
    LAS float* dts = (LAS float*)(lds + 52224); LAS float* das = dts + 128; LAS float* acs = das + 128;
    const int g = h >> 3; const size_t row0 = (size_t)b * SEQ + (size_t)c * 128; const int t0 = c * 128;
    if (tid < 128) { const float raw = bf2f(PA[(row0 + tid) * 2816 + 2560 + h]) + dt_bias[h]; const float dt = softplus(raw); dts[tid] = dt;
        const float v = wave_scan_incl(-dt * __expf(a_log[h]), lane); acs[tid] = v; if (tid == 63) das[0] = v; }
    __syncthreads();
    if (tid >= 64 && tid < 128) acs[tid] += das[0];
    __syncthreads();
    const float total = acs[127];
#pragma unroll 1
    for (int it = 0; it < 2; ++it) { const int idx = tid + it * 512; const int l = idx & 127, pc = idx >> 7; float v[8];
        xbc_conv8(PA, row0 + l, t0 + l, 1024 + h * 64 + pc * 8, cw, cb, h * 64 + pc * 8, v);
        const float f = dts[l] * __expf(total - acs[l]);
#pragma unroll
        for (int e = 0; e < 8; ++e) XT[(pc * 8 + e) * RS + l] = (bf16_t)f2bf(v[e] * f); }
#pragma unroll 1
    for (int it = 0; it < 4; ++it) { const int idx = tid + it * 512; const int l = idx & 127, nc = idx >> 7; float v[8];
        xbc_conv8(PA, row0 + l, t0 + l, 2048 + g * 128 + nc * 8, cw, cb, 1024 + g * 128 + nc * 8, v);
#pragma unroll
        for (int e = 0; e < 8; ++e) BT[(nc * 8 + e) * RS + l] = (bf16_t)f2bf(v[e]); }
    __syncthreads();
    const int fr = lane & 15, fq = lane >> 4;
    f32x4 acc[4];
#pragma unroll
    for (int pt = 0; pt < 4; ++pt) acc[pt] = (f32x4){0.f, 0.f, 0.f, 0.f};
#pragma unroll
    for (int ks = 0; ks < 4; ++ks) { const bf16x8 bfg = *(const LAS bf16x8*)(BT + (wave * 16 + fr) * RS + ks * 32 + fq * 8);
#pragma unroll
        for (int pt = 0; pt < 4; ++pt) { const bf16x8 xf = *(const LAS bf16x8*)(XT + (pt * 16 + fr) * RS + ks * 32 + fq * 8); acc[pt] = mfma16(bfg, xf, acc[pt]); } }
    bf16_t* dst = ST + ((size_t)((b * 128 + c) * 16 + h)) * 8192;
#pragma unroll
    for (int pt = 0; pt < 4; ++pt) { u32x2 w; w.x = pk2(acc[pt][0], acc[pt][1]); w.y = pk2(acc[pt][2], acc[pt][3]); *(u32x2*)(dst + (pt * 16 + fr) * 128 + wave * 16 + fq * 4) = w; }
    if (tid == 0) DEC[(b * 128 + c) * 16 + h] = __expf(total);
    __syncthreads();
}
__device__ __forceinline__ void scan_phase(bf16_t* ST, const float* DEC, int mode, int gtid, int nthr) {
    LAUNDER_V(gtid);
    for (int e2 = gtid; e2 < 131072; e2 += nthr) {
        const int b = e2 >> 16, eb = e2 & 65535; const int h = mode ? (eb >> 14) : (eb >> 12);
        unsigned* p = (unsigned*)ST + (size_t)b * 128 * 65536 + eb;
        const float dconst = exp2f(128.f * log2gamma(h & 3));
        const float* dp = DEC + b * 128 * 16 + (h & 15);
        float c0 = 0.f, c1 = 0.f;
#pragma unroll 1
        for (int c = 0; c < 128; c += 8) { unsigned v[8]; float d[8];
#pragma unroll
            for (int k = 0; k < 8; ++k) { v[k] = p[(size_t)(c + k) * 65536]; d[k] = mode ? dconst : dp[(c + k) * 16]; }
#pragma unroll
            for (int k = 0; k < 8; ++k) { p[(size_t)(c + k) * 65536] = pk2(c0, c1); c0 = c0 * d[k] + bflo(v[k]); c1 = c1 * d[k] + bfhi(v[k]); } }
    }
}
__device__ __forceinline__ void ssd_out_unit(LAS unsigned char* lds, const bf16_t* PA, const bf16_t* ST, bf16_t* MIX, const float* cw, const float* cb, const float* dt_bias, const float* a_log,
                                             const float* d_skip, const float* norm_g, int b, int c, int g, int tid, int lane, int wave) {
    LAUNDER_V(tid); LAUNDER_V(lane); LAUNDER_S(wave);
    constexpr int RS = 136, XR = 72;
    LAS bf16_t* Cs = (LAS bf16_t*)lds;
    LAS bf16_t* Bs = (LAS bf16_t*)(lds + 34816);
    LAS bf16_t* XT = (LAS bf16_t*)(lds + 69632);
    LAS bf16_t* PV = (LAS bf16_t*)(lds + 87040);
    LAS bf16_t* XS = (LAS bf16_t*)(lds + 104448);
    LAS float* dts = (LAS float*)(lds + 122880);
    LAS float* acs = (LAS float*)(lds + 126976);
    LAS float* tmp = (LAS float*)(lds + 69632);
    const size_t row0 = (size_t)b * SEQ + (size_t)c * 128; const int t0 = c * 128;
#pragma unroll 1
    for (int it = 0; it < 2; ++it) { const int idx = tid + it * 512; const int hg = idx >> 7, l = idx & 127, h = g * 8 + hg;
        const float raw = bf2f(PA[(row0 + l) * 2816 + 2560 + h]) + dt_bias[h]; const float dt = softplus(raw); dts[idx] = dt;
        const float v = wave_scan_incl(-dt * __expf(a_log[h]), lane); acs[idx] = v; if (l == 63) tmp[hg] = v; }
    __syncthreads();
#pragma unroll 1
    for (int it = 0; it < 2; ++it) { const int idx = tid + it * 512; if ((idx & 127) >= 64) acs[idx] += tmp[idx >> 7]; }
#pragma unroll 1
    for (int it = 0; it < 4; ++it) { const int idx = tid + it * 512; const int nc = idx & 15, l = idx >> 4; float v[8];
        xbc_conv8(PA, row0 + l, t0 + l, 2304 + g * 128 + nc * 8, cw, cb, 1280 + g * 128 + nc * 8, v); *(LAS u32x4*)(Cs + l * RS + nc * 8) = pack8(v);
        xbc_conv8(PA, row0 + l, t0 + l, 2048 + g * 128 + nc * 8, cw, cb, 1024 + g * 128 + nc * 8, v); *(LAS u32x4*)(Bs + l * RS + nc * 8) = pack8(v); }
    __syncthreads();
    const int fr = lane & 15, fq = lane >> 4; const int l = wave * 16 + fr; const int wodd = wave | 1, nk2 = wave >> 1;
    f32x4 cbt[8];
#pragma unroll
    for (int st = 0; st < 8; ++st) { cbt[st] = (f32x4){0.f, 0.f, 0.f, 0.f};
        if (st <= wodd) {
#pragma unroll
            for (int ks = 0; ks < 4; ++ks) { const bf16x8 af = *(const LAS bf16x8*)(Bs + (st * 16 + fr) * RS + ks * 32 + fq * 8), bf = *(const LAS bf16x8*)(Cs + l * RS + ks * 32 + fq * 8);
                cbt[st] = mfma16(af, bf, cbt[st]); } } }
    float ssq = 0.f;
#pragma unroll 1
    for (int hg = 0; hg < 8; ++hg) {
        const int h = g * 8 + hg;
        __syncthreads();
#pragma unroll 1
        for (int it = 0; it < 2; ++it) { const int idx = tid + it * 512; const int ll = idx & 127, pc = idx >> 7; float v[8];
            xbc_conv8(PA, row0 + ll, t0 + ll, 1024 + h * 64 + pc * 8, cw, cb, h * 64 + pc * 8, v);
            *(LAS u32x4*)(XS + ll * XR + pc * 8) = pack8(v);
            const float dt = dts[hg * 128 + ll];
#pragma unroll
            for (int e = 0; e < 8; ++e) XT[(pc * 8 + e) * RS + ll] = (bf16_t)f2bf(v[e] * dt); }
        { const bf16_t* src = ST + ((size_t)((b * 128 + c) * 16 + h)) * 8192;
#pragma unroll 1
            for (int it = 0; it < 2; ++it) { const int idx = tid + it * 512; const int nc = idx & 15, p = idx >> 4; *(LAS u32x4*)(PV + p * RS + nc * 8) = *(const u32x4*)(src + p * 128 + nc * 8); } }
        __syncthreads();
        int lc = l; LAUNDER_V(lc);
        const LAS float* ah = acs + hg * 128; const float al = ah[l];
        f32x4 accd[4], acco[4];
#pragma unroll
        for (int pt = 0; pt < 4; ++pt) { accd[pt] = (f32x4){0.f, 0.f, 0.f, 0.f}; acco[pt] = (f32x4){0.f, 0.f, 0.f, 0.f}; }
#pragma unroll
        for (int k2 = 0; k2 < 4; ++k2) {
            if (k2 <= nk2) {
                const int s0 = k2 * 32 + fq * 4, s1 = s0 + 16;
                const f32x4 a0 = *(const LAS f32x4*)(ah + s0), a1 = *(const LAS f32x4*)(ah + s1);
                f32x4 p0, p1;
#pragma unroll
                for (int r = 0; r < 4; ++r) { p0[r] = (s0 + r <= lc) ? cbt[2 * k2][r] * __expf(fminf(al - a0[r], 0.f)) : 0.f; p1[r] = (s1 + r <= lc) ? cbt[2 * k2 + 1][r] * __expf(fminf(al - a1[r], 0.f)) : 0.f; }
                const bf16x8 pf = packf8(p0, p1);
#pragma unroll
                for (int pt = 0; pt < 4; ++pt) { const LAS bf16_t* xp = XT + (pt * 16 + fr) * RS + s0;
                    const bf16x8 xf = cat44(*(const LAS bf16x4*)xp, *(const LAS bf16x4*)(xp + 16)); accd[pt] = mfma16(xf, pf, accd[pt]); }
            }
        }
#pragma unroll
        for (int ks = 0; ks < 4; ++ks) { const bf16x8 cf = *(const LAS bf16x8*)(Cs + l * RS + ks * 32 + fq * 8);
#pragma unroll
            for (int pt = 0; pt < 4; ++pt) { const bf16x8 pvf = *(const LAS bf16x8*)(PV + (pt * 16 + fr) * RS + ks * 32 + fq * 8); acco[pt] = mfma16(pvf, cf, acco[pt]); } }
        const float el = __expf(al), dsk = d_skip[h];
#pragma unroll
        for (int pt = 0; pt < 4; ++pt) { const int p = pt * 16 + fq * 4;
            const u32x2 xv = *(const LAS u32x2*)(XS + l * XR + p); const u32x2 zv = *(const u32x2*)(PA + (row0 + l) * 2816 + h * 64 + p);
            const float xs0 = bflo(xv.x), xs1 = bfhi(xv.x), xs2 = bflo(xv.y), xs3 = bfhi(xv.y);
            float y0 = accd[pt][0] + el * acco[pt][0] + dsk * xs0, y1 = accd[pt][1] + el * acco[pt][1] + dsk * xs1, y2 = accd[pt][2] + el * acco[pt][2] + dsk * xs2, y3 = accd[pt][3] + el * acco[pt][3] + dsk * xs3;
            y0 *= silu(bflo(zv.x)); y1 *= silu(bfhi(zv.x)); y2 *= silu(bflo(zv.y)); y3 *= silu(bfhi(zv.y));
            ssq += (y0 * y0 + y1 * y1) + (y2 * y2 + y3 * y3);
            u32x2 w; w.x = pk2(y0, y1); w.y = pk2(y2, y3); *(u32x2*)(MIX + (row0 + l) * 2048 + h * 64 + p) = w; }
    }
    ssq += __shfl_xor(ssq, 16); ssq += __shfl_xor(ssq, 32);
    const float rstd = 1.0f / sqrtf(ssq * (1.f / 512.f) + EPS);
#pragma unroll 1
    for (int hg = 0; hg < 8; ++hg)
#pragma unroll
        for (int pt = 0; pt < 4; ++pt) { const int ch = (g * 8 + hg) * 64 + pt * 16 + fq * 4; u32x2* q = (u32x2*)(MIX + (row0 + l) * 2048 + ch); const u32x2 v = *q; const f32x4 ng = *(const f32x4*)(norm_g + ch);
            u32x2 w; w.x = pk2(bflo(v.x) * rstd * ng[0], bfhi(v.x) * rstd * ng[1]); w.y = pk2(bflo(v.y) * rstd * ng[2], bfhi(v.y) * rstd * ng[3]); *q = w; }
    __syncthreads();
}

__device__ __forceinline__ void rope_pair8(const bf16_t* src, float pos, const float* inv, float scale, float* o1, float* o2) {
    const u32x4 av = *(const u32x4*)src, cv = *(const u32x4*)(src + 64); float x1[8], x2[8]; unpack8(av, x1); unpack8(cv, x2);
#pragma unroll
    for (int e = 0; e < 8; ++e) { float s, co; sincos_ang(pos * inv[e], s, co); o1[e] = (x1[e] * co - x2[e] * s) * scale; o2[e] = (x2[e] * co + x1[e] * s) * scale; }
}
__device__ __forceinline__ void ret_local_unit(LAS unsigned char* lds, const bf16_t* PB, bf16_t* ST, const float* inv_ret, int b, int c, int h, int tid, int lane, int wave) {
    LAUNDER_V(tid); LAUNDER_V(lane); LAUNDER_S(wave);
    constexpr int RS = 136;
    LAS bf16_t* VT = (LAS bf16_t*)lds;
    LAS bf16_t* KT = (LAS bf16_t*)(lds + 69632);
    const size_t row0 = (size_t)b * SEQ + (size_t)c * 128; const float lg = log2gamma(h);
#pragma unroll 1
    for (int it = 0; it < 2; ++it) { const int idx = tid + it * 512; const int l = idx & 127, ic = idx >> 7; float o1[8], o2[8];
        rope_pair8(PB + (row0 + l) * 3072 + 512 + h * 128 + ic * 8, (float)(c * 128 + l), inv_ret + ic * 8, 0.08838834764831845f * exp2f((float)(127 - l) * lg), o1, o2);
#pragma unroll
        for (int e = 0; e < 8; ++e) { KT[(ic * 8 + e) * RS + l] = (bf16_t)f2bf(o1[e]); KT[(64 + ic * 8 + e) * RS + l] = (bf16_t)f2bf(o2[e]); } }
#pragma unroll 1
    for (int it = 0; it < 8; ++it) { const int idx = tid + it * 512; const int l = idx & 127, vc = idx >> 7;
        const u32x4 a = *(const u32x4*)(PB + (row0 + l) * 3072 + 1024 + h * 256 + vc * 8); LAS bf16_t* dst = VT + (vc * 8) * RS + l;
        dst[0 * RS] = (bf16_t)(a.x & 0xffffu); dst[1 * RS] = (bf16_t)(a.x >> 16); dst[2 * RS] = (bf16_t)(a.y & 0xffffu); dst[3 * RS] = (bf16_t)(a.y >> 16);
        dst[4 * RS] = (bf16_t)(a.z & 0xffffu); dst[5 * RS] = (bf16_t)(a.z >> 16); dst[6 * RS] = (bf16_t)(a.w & 0xffffu); dst[7 * RS] = (bf16_t)(a.w >> 16); }
    __syncthreads();
    const int fr = lane & 15, fq = lane >> 4;
    f32x4 acc[2][8];
#pragma unroll
    for (int vi = 0; vi < 2; ++vi)
#pragma unroll
        for (int dt = 0; dt < 8; ++dt) acc[vi][dt] = (f32x4){0.f, 0.f, 0.f, 0.f};
#pragma unroll
    for (int ks = 0; ks < 4; ++ks) { bf16x8 vf[2];
#pragma unroll
        for (int vi = 0; vi < 2; ++vi) vf[vi] = *(const LAS bf16x8*)(VT + ((2 * wave + vi) * 16 + fr) * RS + ks * 32 + fq * 8);
#pragma unroll
        for (int dt = 0; dt < 8; ++dt) { const bf16x8 kf = *(const LAS bf16x8*)(KT + (dt * 16 + fr) * RS + ks * 32 + fq * 8);
#pragma unroll
            for (int vi = 0; vi < 2; ++vi) acc[vi][dt] = mfma16(kf, vf[vi], acc[vi][dt]); } }
    bf16_t* dst = ST + ((size_t)((b * 128 + c) * 4 + h)) * 32768;
#pragma unroll
    for (int vi = 0; vi < 2; ++vi)
#pragma unroll
        for (int dt = 0; dt < 8; ++dt) { u32x2 w; w.x = pk2(acc[vi][dt][0], acc[vi][dt][1]); w.y = pk2(acc[vi][dt][2], acc[vi][dt][3]); *(u32x2*)(dst + ((2 * wave + vi) * 16 + fr) * 128 + dt * 16 + fq * 4) = w; }
    __syncthreads();
}
__device__ __forceinline__ void ret_out_unit(LAS unsigned char* lds, const bf16_t* PB, const bf16_t* ST, bf16_t* MIX, const float* inv_ret, const float* gn_g, const float* gn_b,
                                             int b, int c, int h, int tid, int lane, int wave) {
    LAUNDER_V(tid); LAUNDER_V(lane); LAUNDER_S(wave);
    constexpr int RS = 136;
    LAS bf16_t* Qs = (LAS bf16_t*)lds;
    LAS bf16_t* Ks = (LAS bf16_t*)(lds + 34816);
    LAS bf16_t* VT = (LAS bf16_t*)(lds + 69632);
    LAS bf16_t* PV = (LAS bf16_t*)(lds + 104448);
    const size_t row0 = (size_t)b * SEQ + (size_t)c * 128; const float lg = log2gamma(h);
    const bf16_t* stsrc = ST + ((size_t)((b * 128 + c) * 4 + h)) * 32768;
#pragma unroll 1
    for (int it = 0; it < 2; ++it) { const int idx = tid + it * 512; const int ic = idx & 7, l = idx >> 3; float o1[8], o2[8]; const float pos = (float)(c * 128 + l);
        rope_pair8(PB + (row0 + l) * 3072 + h * 128 + ic * 8, pos, inv_ret + ic * 8, 1.0f, o1, o2);
        *(LAS u32x4*)(Qs + l * RS + ic * 8) = pack8(o1); *(LAS u32x4*)(Qs + l * RS + 64 + ic * 8) = pack8(o2);
        rope_pair8(PB + (row0 + l) * 3072 + 512 + h * 128 + ic * 8, pos, inv_ret + ic * 8, 0.08838834764831845f, o1, o2);
        *(LAS u32x4*)(Ks + l * RS + ic * 8) = pack8(o1); *(LAS u32x4*)(Ks + l * RS + 64 + ic * 8) = pack8(o2); }
    const int fr = lane & 15, fq = lane >> 4; const int l = wave * 16 + fr; const int wodd = wave | 1, nk2 = wave >> 1;
    f32x4 acc[16];
#pragma unroll
    for (int vt = 0; vt < 16; ++vt) acc[vt] = (f32x4){0.f, 0.f, 0.f, 0.f};
    bf16x8 pf[4], qs[4];
#pragma unroll
    for (int vh = 0; vh < 2; ++vh) {
        if (vh == 1) __syncthreads();
#pragma unroll 1
        for (int it = 0; it < 4; ++it) { const int idx = tid + it * 512; const int s = idx & 127, vc = idx >> 7;
            const u32x4 a = *(const u32x4*)(PB + (row0 + s) * 3072 + 1024 + h * 256 + vh * 128 + vc * 8); LAS bf16_t* dst = VT + (vc * 8) * RS + s;
            dst[0 * RS] = (bf16_t)(a.x & 0xffffu); dst[1 * RS] = (bf16_t)(a.x >> 16); dst[2 * RS] = (bf16_t)(a.y & 0xffffu); dst[3 * RS] = (bf16_t)(a.y >> 16);
            dst[4 * RS] = (bf16_t)(a.z & 0xffffu); dst[5 * RS] = (bf16_t)(a.z >> 16); dst[6 * RS] = (bf16_t)(a.w & 0xffffu); dst[7 * RS] = (bf16_t)(a.w >> 16); }
#pragma unroll 1
        for (int it = 0; it < 4; ++it) { const int idx = tid + it * 512; const int dc = idx & 15, v = idx >> 4; *(LAS u32x4*)(PV + v * RS + dc * 8) = *(const u32x4*)(stsrc + (vh * 128 + v) * 128 + dc * 8); }
        __syncthreads();
        if (vh == 0) {
            f32x4 sc[8];
#pragma unroll
            for (int st = 0; st < 8; ++st) { sc[st] = (f32x4){0.f, 0.f, 0.f, 0.f};
                if (st <= wodd) {
#pragma unroll
                    for (int ks = 0; ks < 4; ++ks) { const bf16x8 kf = *(const LAS bf16x8*)(Ks + (st * 16 + fr) * RS + ks * 32 + fq * 8), qf = *(const LAS bf16x8*)(Qs + l * RS + ks * 32 + fq * 8);
                        sc[st] = mfma16(kf, qf, sc[st]); } } }
#pragma unroll
            for (int k2 = 0; k2 < 4; ++k2) { f32x4 p0, p1; const int s0 = k2 * 32 + fq * 4, s1 = s0 + 16;
#pragma unroll
                for (int r = 0; r < 4; ++r) { p0[r] = (s0 + r <= l) ? sc[2 * k2][r] * exp2f((float)(l - s0 - r) * lg) : 0.f; p1[r] = (s1 + r <= l) ? sc[2 * k2 + 1][r] * exp2f((float)(l - s1 - r) * lg) : 0.f; }
                pf[k2] = packf8(p0, p1); }
            const float fs = exp2f((float)(l + 1) * lg);
#pragma unroll
            for (int ks = 0; ks < 4; ++ks) { const u32x4 qv = *(const LAS u32x4*)(Qs + l * RS + ks * 32 + fq * 8); float x[8]; unpack8(qv, x);
#pragma unroll
                for (int e = 0; e < 8; ++e) x[e] *= fs;
                qs[ks] = __builtin_bit_cast(bf16x8, pack8(x)); }
        }
#pragma unroll
        for (int vt = 0; vt < 8; ++vt) { f32x4 a = acc[vh * 8 + vt];
#pragma unroll
            for (int ks = 0; ks < 4; ++ks) { const bf16x8 pvf = *(const LAS bf16x8*)(PV + (vt * 16 + fr) * RS + ks * 32 + fq * 8); a = mfma16(pvf, qs[ks], a); }
#pragma unroll
            for (int k2 = 0; k2 < 4; ++k2) { if (k2 <= nk2) { const LAS bf16_t* vp = VT + (vt * 16 + fr) * RS + k2 * 32 + fq * 4;
                    const bf16x8 vf = cat44(*(const LAS bf16x4*)vp, *(const LAS bf16x4*)(vp + 16)); a = mfma16(vf, pf[k2], a); } }
            acc[vh * 8 + vt] = a; __builtin_amdgcn_sched_barrier(0); }
    }
    float s = 0.f;
#pragma unroll
    for (int vt = 0; vt < 16; ++vt) s += (acc[vt][0] + acc[vt][1]) + (acc[vt][2] + acc[vt][3]);
    s += __shfl_xor(s, 16); s += __shfl_xor(s, 32);
    const float mean = s * (1.f / 256.f); float qv = 0.f;
#pragma unroll
    for (int vt = 0; vt < 16; ++vt) { acc[vt] = acc[vt] - mean; qv += (acc[vt][0] * acc[vt][0] + acc[vt][1] * acc[vt][1]) + (acc[vt][2] * acc[vt][2] + acc[vt][3] * acc[vt][3]); }
    qv += __shfl_xor(qv, 16); qv += __shfl_xor(qv, 32);
    const float rstd = 1.0f / sqrtf(qv * (1.f / 256.f) + EPS);
#pragma unroll
    for (int vt = 0; vt < 16; ++vt) { const int ch = h * 256 + vt * 16 + fq * 4;
        const u32x2 gv = *(const u32x2*)(PB + (row0 + l) * 3072 + 2048 + ch); const f32x4 gg = *(const f32x4*)(gn_g + ch), gb = *(const f32x4*)(gn_b + ch);
        const f32x4 y = acc[vt] * rstd * gg + gb;
        u32x2 w; w.x = pk2(silu(bflo(gv.x)) * y[0], silu(bfhi(gv.x)) * y[1]); w.y = pk2(silu(bflo(gv.y)) * y[2], silu(bfhi(gv.y)) * y[3]);
        *(u32x2*)(MIX + (row0 + l) * 2048 + 1024 + ch) = w; }
    __syncthreads();
}

#ifdef PROBE_CAT
#define TICK(cat) do { if (blockIdx.x == 0 && threadIdx.x == 0) { volatile LAS unsigned long long* pa = (volatile LAS unsigned long long*)(lds + PTR_OFF + 256); const unsigned long long now = __builtin_amdgcn_s_memrealtime(); pa[cat] += now - pa[15]; pa[15] = now; } } while (0)
#else
#define TICK(cat) do {} while (0)
#endif
#define GSYNC(cat) do { TICK(cat); XcdBarrier xb_; xb_.bar = (unsigned*)ldws(lds); xb_.x = xb_xcc_id(); xb_.st = (volatile LAS unsigned*)(lds + PTR_OFF + 224); xcd_barrier(xb_); TICK(1); } while (0)

__global__ void __launch_bounds__(512, 2) mega_fwd(Params P) {
    extern __shared__ __attribute__((aligned(16))) unsigned char lds_raw[];
    LAS unsigned char* lds = (LAS unsigned char*)lds_raw;
    cg::grid_group grid = cg::this_grid();
    const int tid = threadIdx.x, lane = tid & 63, wave = __builtin_amdgcn_readfirstlane(tid >> 6);
    const int G = gridDim.x, bid = blockIdx.x, gw = bid * 8 + wave, NGW = G * 8, gtid = bid * 512 + tid, nthr = G * 512;
    if (tid == 0) { volatile LAS unsigned long long* t = (volatile LAS unsigned long long*)(lds + PTR_OFF);
#pragma unroll
        for (int i = 0; i < 25; ++i) t[i] = (unsigned long long)P.in[i];
        t[25] = (unsigned long long)P.out; t[26] = (unsigned long long)P.ws; t[27] = 0ull; t[28] = 0ull;
#pragma unroll
        for (int i = 32; i < 48; ++i) t[i] = 0ull;
#ifdef PROBE_CAT
        t[32 + 15] = __builtin_amdgcn_s_memrealtime();
#endif
    }
    if (blockIdx.x == 0) { unsigned* bw = (unsigned*)P.ws; for (int i = tid; i < XCD_BAR_WORDS; i += 512) bw[i] = 0u; }
    __syncthreads();
#define Wb ((bf16_t*)(ldws(lds) + WS_W))
#define XN ((bf16_t*)(ldws(lds) + WS_XN))
#define PROJ ((bf16_t*)(ldws(lds) + WS_PROJ))
#define MIX ((bf16_t*)(ldws(lds) + WS_MIX))
#define ST ((bf16_t*)(ldws(lds) + WS_ST))
#define DEC ((float*)(ldws(lds) + WS_DEC))
#define TAB ((float*)(ldws(lds) + WS_TAB))
#define X (ldout(lds))

    { const float* x = ldin(lds, 0);
        for (size_t i = (size_t)gtid; i < (size_t)M * DM / 8; i += (size_t)nthr) { const f32x4 a = *(const f32x4*)(x + i * 8), c = *(const f32x4*)(x + i * 8 + 4);
            u32x4 w; w.x = pk2(a[0], a[1]); w.y = pk2(a[2], a[3]); w.z = pk2(c[0], c[1]); w.w = pk2(c[2], c[3]); *(u32x4*)(XN + i * 8) = w; }
        if (bid == 0 && tid < 72) {
            float v;
            if (tid < 64) { const float t = (float)tid * (1.0f / 63.0f); v = 1.0f / (float)pow(10000.0, (double)t); }
            else { v = (float)pow(500000.0, -(double)(tid - 64) / 8.0); }
            TAB[tid] = v; }
        convert_layer(0, lds, gw, NGW, lane, wave, gtid, nthr);
    }
    __builtin_amdgcn_fence(__ATOMIC_RELEASE, "agent"); grid.sync(); __builtin_amdgcn_fence(__ATOMIC_ACQUIRE, "agent");
    (void)xcd_barrier_post((unsigned*)ldws(lds), (volatile LAS unsigned*)(lds + PTR_OFF + 224));
    TICK(6);

#pragma unroll 1
    for (int L = 0; L < 4; ++L) {
        const int e = L >> 1; const bool odd = (L & 1) != 0;
#pragma unroll 1
        for (int part = 0; part < 2; ++part) {
            if (part == 0) {
                const int nsub = odd ? 2 : 1;
#pragma unroll 1
                for (int sub = 0; sub < nsub; ++sub) {
                    const int N = odd ? (sub ? 3072 : 2816) : 1792;
                    { pg8::Gemm gm{XN, Wb + WO_IN + (size_t)(sub ? 2816 : 0) * 1024, M, N, 1024}; pg8::StaticOrder S; int bl = bid; LAUNDER_S(bl); S.init(M, N, G, bl);
                        pg8::EpiBf16<0> E{PROJ, N, nullptr, 0, 0, 1.f};
                        pg8::gemm_phase<pg8::EpiBf16<0>, pg8::StaticOrder, true, true>(lds, gm, S, E); }
                    GSYNC(2);
                    if (!odd) {

#ifndef NO_ATTN
for (int u = bid; u < 512; u += G) attn_unit(lds, PROJ, MIX, ldin(lds, 9) + e * 8, TAB + 64, u >> 8, (u >> 1) & 127, u & 1, tid, lane, wave);
#endif


#ifndef NO_CONV
for (int u = bid; u < 1024; u += G) conv_unit(lds, PROJ, MIX, ldin(lds, 10) + (size_t)e * 31 * 512, ldin(lds, 11) + e * 512, ldin(lds, 12) + e * 512, ldin(lds, 13) + e * 512, u >> 9, u & 511, tid, lane, wave);
#endif

                        GSYNC(5);
                    } else if (sub == 0) {
                        const float* cw = ldin(lds, 16) + (size_t)e * 4 * 1536; const float* cb = ldin(lds, 17) + e * 1536; const float* dtb = ldin(lds, 18) + e * 16; const float* alog = ldin(lds, 19) + e * 16;

#ifndef NO_SSDL
for (int u = bid; u < 4096; u += G) ssd_local_unit(lds, PROJ, ST, DEC, cw, cb, dtb, alog, u >> 11, (u >> 4) & 127, u & 15, tid, lane, wave);
#endif

                        GSYNC(7);

#ifndef NO_SCAN
scan_phase(ST, DEC, 0, gtid, nthr);
#endif

                        GSYNC(8);

#ifndef NO_SSDO
for (int u = bid; u < 512; u += G) ssd_out_unit(lds, PROJ, ST, MIX, cw, cb, dtb, alog, ldin(lds, 20) + e * 16, ldin(lds, 21) + e * 1024, u >> 8, (u >> 1) & 127, u & 1, tid, lane, wave);
#endif

                        GSYNC(9);
                    } else {

#ifndef NO_RETL
for (int u = bid; u < 1024; u += G) ret_local_unit(lds, PROJ, ST, TAB, u >> 9, (u >> 2) & 127, u & 3, tid, lane, wave);
#endif

                        GSYNC(10);

#ifndef NO_SCAN
scan_phase(ST, DEC, 1, gtid, nthr);
#endif

                        GSYNC(8);

#ifndef NO_RETO
for (int u = bid; u < 1024; u += G) ret_out_unit(lds, PROJ, ST, MIX, TAB, ldin(lds, 22) + e * 1024, ldin(lds, 23) + e * 1024, u >> 9, (u >> 2) & 127, u & 3, tid, lane, wave);
#endif

                        GSYNC(11);
                    }
                }
            } else {
                pg8::Gemm gm{XN, Wb + WO_GU, M, 5632, 1024}; pg8::StaticOrder S; int bl = bid; LAUNDER_S(bl); S.init(M, 5632, G, bl);
                pg8::EpiSwiglu E{PROJ, FFH};
                pg8::gemm_phase<pg8::EpiSwiglu, pg8::StaticOrder, true, true>(lds, gm, S, E);
                GSYNC(3);
            }
            {
                const int K = part ? FFH : (odd ? 2048 : 1024);
                pg8::Gemm gm{part ? PROJ : MIX, Wb + (part ? WO_D : WO_OUT), M, 1024, K}; pg8::StaticOrder S; int bl = bid; LAUNDER_S(bl); S.init(M, 1024, G, bl);
                pg8::EpiRes E{(L == 0 && part == 0) ? ldin(lds, 0) : X, X, 1024, ALPHA};
                pg8::gemm_phase<pg8::EpiRes, pg8::StaticOrder, true, true>(lds, gm, S, E);
            }
            GSYNC(4);

#ifndef NO_LN
ln_phase(X, XN, ldin(lds, part ? 3 : 1) + L * 1024, ldin(lds, part ? 4 : 2) + L * 1024, gw, NGW, lane);
#endif


#ifndef NO_CVT
if (part == 1 && L < 3) convert_layer(L + 1, lds, gw, NGW, lane, wave, gtid, nthr);
#endif

            GSYNC(6);
        }
    }
#ifdef PROBE_CAT
    if (blockIdx.x == 0 && threadIdx.x == 0) { volatile LAS unsigned long long* pa = (volatile LAS unsigned long long*)(lds + PTR_OFF + 256); const unsigned long long d = pa[PROBE_CAT], t0 = __builtin_amdgcn_s_memrealtime();
        while (__builtin_amdgcn_s_memrealtime() - t0 < d) __builtin_amdgcn_s_sleep(8); }
#endif
}
}

extern "C" void kernel_launch(void* const* d_in, const int* in_sizes, int n_in, void* d_out, int out_size, void* d_ws, size_t ws_size, hipStream_t stream) {
    static int grid = 0;
    if (grid == 0) {
        int dev = 0, cus = 0, per_cu = 0;
        hipGetDevice(&dev); hipDeviceGetAttribute(&cus, hipDeviceAttributeMultiprocessorCount, dev);
        hipFuncSetAttribute((const void*)mk::mega_fwd, hipFuncAttributeMaxDynamicSharedMemorySize, mk::LDS_BYTES);
        hipOccupancyMaxActiveBlocksPerMultiprocessor(&per_cu, (const void*)mk::mega_fwd, 512, mk::LDS_BYTES);
        if (per_cu < 1) per_cu = 1;
        (void)hipGetLastError();
        grid = cus * 1;
        if (grid <= 0) grid = 256;
    }
    mk::Params p{};
    for (int i = 0; i < 25; ++i) p.in[i] = (const float*)d_in[i];
    p.out = (float*)d_out; p.ws = (unsigned char*)d_ws;
    void* args[] = {&p};
    hipError_t err = hipLaunchCooperativeKernel((const void*)mk::mega_fwd, dim3(grid), dim3(512), args, mk::LDS_BYTES, stream);
    if (err != hipSuccess) fprintf(stderr, "cooperative launch failed: %s (grid %d)\n", hipGetErrorString(err), grid);
}
```

```cpp
#include <hip/hip_runtime.h>
#include <hip/hip_cooperative_groups.h>
#include <cstdio>
#include <cstdint>
#include <cmath>
namespace pg8 {
#define PG8_LAS __attribute__((address_space(3)))
typedef unsigned short bf16_t;
typedef short bf16x8 __attribute__((ext_vector_type(8)));
typedef float f32x4 __attribute__((ext_vector_type(4)));
typedef unsigned u32x4 __attribute__((ext_vector_type(4)));
constexpr int BM = 256, BK = 64, HALF = 128, HTB = HALF * BK * 2  , STAGE_BYTES = 8 * HTB, NXCD = 8, WGM = 8;

__host__ __device__ __forceinline__ int lds_byte(int r, int c) { const int st = (r >> 4) * 2 + (c >> 5), rr = r & 15, cc = c & 31, ob = rr * 64 + cc * 2; return st * 1024 + (ob ^ (((ob >> 9) & 1) << 5)); }
__host__ __device__ __forceinline__ void stage_rc(int b, int& R, int& C) { const int st = b / 1024, sb = b % 1024, swz = sb ^ (((sb >> 9) & 1) << 5); R = (st >> 1) * 16 + swz / 64; C = (st & 1) * 32 + (swz % 64) / 2; }
__host__ __device__ __forceinline__ int perm32(int rho) { const int n = rho >> 4, i = rho & 15; return 8 * (i >> 2) + 4 * n + (i & 3); }

struct Unit { int pm, pn; };
struct Gemm { const bf16_t* A; const bf16_t* Bt; int M, N, K; };

struct StaticOrder {
    int nM, nN, nwg, G, c;
    __host__ __device__ void init(int M, int N, int G_, int c_) { nM = M / BM; nN = N / BM; nwg = nM * nN; G = G_; c = c_; }
    __host__ __device__ bool next(int i, Unit& u) const {
        const long L = (long)i * G + c; if (L >= nwg) return false;
        int wgid = (int)L; { const int q = nwg / NXCD, r = nwg % NXCD, xcd = wgid % NXCD, off = wgid / NXCD; wgid = (xcd < r ? xcd * (q + 1) : r * (q + 1) + (xcd - r) * q) + off; }
        const int nig = WGM * nN, gid = wgid / nig, fm = gid * WGM, gsz = (nM - fm) < WGM ? (nM - fm) : WGM;
        u.pm = fm + ((wgid % nig) % gsz); u.pn = (wgid % nig) / gsz; return true;
    }
    __device__ __forceinline__ void a_ready(const Unit&) const {}
    __device__ __forceinline__ void done(const Unit&) const {}
};

__device__ __forceinline__ unsigned cvt_pk_bf16(float lo, float hi) { unsigned r; asm volatile("v_cvt_pk_bf16_f32 %0, %1, %2" : "=v"(r) : "v"(lo), "v"(hi)); return r; }
typedef float f32x2 __attribute__((ext_vector_type(2)));
__device__ __forceinline__ f32x2 gelu_pk(f32x2 v) {
    const f32x2 av = __builtin_elementwise_abs(v), d = av * 0.2316418882f + 1.0f;
    f32x2 t; t.x = __builtin_amdgcn_rcpf(d.x); t.y = __builtin_amdgcn_rcpf(d.y);
    f32x2 q = t * 0.5307027145f + (-0.7265760135f); q = q * t + 0.7107068705f; q = q * t + (-0.142248368f); q = q * t + 0.127414796f; q = q * t;
    const f32x2 s = (v * v) * (-0.72134752044f);
    f32x2 e; e.x = __builtin_amdgcn_exp2f(s.x); e.y = __builtin_amdgcn_exp2f(s.y);
    const f32x2 m = v * (q * e), r = v - m;
    f32x2 o; o.x = v.x < 0.f ? m.x : r.x; o.y = v.y < 0.f ? m.y : r.y; return o;
}

template <int ACT  > struct EpiBf16 {
    static constexpr bool PERM = true, AFTER_DRAIN = false; static_assert(ACT == 0 || ACT == 1, "EpiBf16: ACT is 0 (none) or 1 (gelu_pk)");
    bf16_t* O; int ldc; const float* bias; int split_cols; size_t split_stride; float scale0;
    __device__ __forceinline__ void operator()(const f32x4 (&acc)[2][2][4][2], const Unit& u, int wr, int wc, int fr, int fq) const {
        const int row0 = u.pm * BM + wr * 64 + fr; int colt = u.pn * BM; bf16_t* base = O;
        float sc = 1.f; if (split_cols) { const int t = colt / split_cols; base += (size_t)t * split_stride; colt -= t * split_cols; if (t == 0) sc = scale0; }
        const int col0 = colt + wc * 32 + 8 * fq, bcol0 = u.pn * BM + wc * 32 + 8 * fq;
        f32x4 bv[2][2];
#pragma unroll
        for (int bj = 0; bj < 2; ++bj)
#pragma unroll
            for (int n = 0; n < 2; ++n) bv[bj][n] = bias ? *(const f32x4*)(bias + bcol0 + bj * HALF + 4 * n) : (f32x4){0.f, 0.f, 0.f, 0.f};
#pragma unroll
        for (int ai = 0; ai < 2; ++ai)
#pragma unroll
            for (int m = 0; m < 4; ++m) { bf16_t* rowp = base + (size_t)(row0 + ai * HALF + m * 16) * ldc + col0;
#pragma unroll
                for (int bj = 0; bj < 2; ++bj) { f32x4 v0 = acc[ai][bj][m][0] + bv[bj][0], v1 = acc[ai][bj][m][1] + bv[bj][1];
                    if (ACT == 1) { f32x2 a = gelu_pk((f32x2){v0[0], v0[1]}), b = gelu_pk((f32x2){v0[2], v0[3]}), c = gelu_pk((f32x2){v1[0], v1[1]}), d = gelu_pk((f32x2){v1[2], v1[3]});
                        v0 = (f32x4){a.x, a.y, b.x, b.y}; v1 = (f32x4){c.x, c.y, d.x, d.y}; }
                    v0 = v0 * sc; v1 = v1 * sc; u32x4 w; w.x = cvt_pk_bf16(v0[0], v0[1]); w.y = cvt_pk_bf16(v0[2], v0[3]); w.z = cvt_pk_bf16(v1[0], v1[1]); w.w = cvt_pk_bf16(v1[2], v1[3]);
                    *(u32x4*)(rowp + bj * HALF) = w; } }
    }
};
__device__ __forceinline__ float silu_f(float x) { return x / (1.0f + __expf(-x)); }
struct EpiSwiglu {
    static constexpr bool PERM = true, AFTER_DRAIN = false;
    bf16_t* O; int ldc;
    __device__ __forceinline__ void operator()(const f32x4 (&acc)[2][2][4][2], const Unit& u, int wr, int wc, int fr, int fq) const {
        const int row0 = u.pm * BM + wr * 64 + fr; const int col0 = u.pn * HALF + wc * 32 + 8 * fq;
#pragma unroll
        for (int ai = 0; ai < 2; ++ai)
#pragma unroll
            for (int m = 0; m < 4; ++m) { bf16_t* rowp = O + (size_t)(row0 + ai * HALF + m * 16) * ldc + col0;
                const f32x4 g0 = acc[ai][0][m][0], g1 = acc[ai][0][m][1], u0 = acc[ai][1][m][0], u1 = acc[ai][1][m][1];
                u32x4 w;
                w.x = cvt_pk_bf16(silu_f(g0[0]) * u0[0], silu_f(g0[1]) * u0[1]); w.y = cvt_pk_bf16(silu_f(g0[2]) * u0[2], silu_f(g0[3]) * u0[3]);
                w.z = cvt_pk_bf16(silu_f(g1[0]) * u1[0], silu_f(g1[1]) * u1[1]); w.w = cvt_pk_bf16(silu_f(g1[2]) * u1[2], silu_f(g1[3]) * u1[3]);
                *(u32x4*)rowp = w; }
    }
};
struct EpiRes {
    static constexpr bool PERM = false, AFTER_DRAIN = false;
    const float* res; float* out; int ldc; float alpha;
    __device__ __forceinline__ void operator()(const f32x4 (&acc)[2][2][4][2], const Unit& u, int wr, int wc, int fr, int fq) const {
        const int row0 = u.pm * BM + wr * 64 + fr, col0 = u.pn * BM + wc * 32 + 4 * fq;
#pragma unroll
        for (int ai = 0; ai < 2; ++ai)
#pragma unroll
            for (int m = 0; m < 4; ++m) { const size_t off = (size_t)(row0 + ai * HALF + m * 16) * ldc + col0;
#pragma unroll
                for (int bj = 0; bj < 2; ++bj)
#pragma unroll
                    for (int n = 0; n < 2; ++n) { const f32x4 x = *(const f32x4*)(res + off + bj * HALF + n * 16);
                        *(f32x4*)(out + off + bj * HALF + n * 16) = x * alpha + acc[ai][bj][m][n]; } }
    }
};
template <class Epi, class Sched, bool ALIGN_EPI = false, bool SP2 = false>
__device__ __forceinline__ void gemm_phase(PG8_LAS unsigned char* lds, const Gemm g, const Sched& S, const Epi& E) {
    int tid_l = threadIdx.x; asm volatile("" : "+v"(tid_l)); const int tid = tid_l, wid = __builtin_amdgcn_readfirstlane(tid >> 6), lane = tid & 63, wr = wid >> 2, wc = wid & 3, fr = lane & 15, fq = lane >> 4;
    const int K = g.K, nt = K / BK;
    unsigned voffA[2], voffB[2];
#pragma unroll
    for (int i = 0; i < 2; ++i) { int R, C; stage_rc(tid * 16 + i * 8192, R, C); const int Rb = Epi::PERM ? ((R & ~31) + perm32(R & 31)) : R;
        voffA[i] = (unsigned)(R * K + C) * 2u; voffB[i] = (unsigned)(Rb * K + C) * 2u; }
    const size_t kstep = (size_t)(BK * 2);
    const size_t hstep = (size_t)HALF * K * 2;
    const size_t tstep = 2 * hstep;
    const unsigned ldsw = (unsigned)wid * 1024u;
    const int aoff = lds_byte(wr * 64 + fr, fq * 8), boff = lds_byte(wc * 32 + fr, fq * 8);
#define PG8_SA(b, h) (((b) * 2 + (h)) * HTB)
#define PG8_SB(b, h) ((4 + (b) * 2 + (h)) * HTB)
#define PG8_STAGE(bufoff, gbase, voff) do { _Pragma("unroll") for (int _i = 0; _i < 2; ++_i) \
        __builtin_amdgcn_global_load_lds((const unsigned*)((const char*)(gbase) + (voff)[_i]), (PG8_LAS unsigned*)(lds + (bufoff) + ldsw + _i * 8192), 16, 0, 0); } while (0)
#define PG8_LDA(dst, b, h) do { _Pragma("unroll") for (int m = 0; m < 4; ++m) _Pragma("unroll") for (int k = 0; k < 2; ++k) dst[m][k] = *(const PG8_LAS bf16x8*)(lds + PG8_SA(b, h) + aoff + m * 2048 + k * 1024); } while (0)
#define PG8_LDB(dst, b, h) do { _Pragma("unroll") for (int n = 0; n < 2; ++n) _Pragma("unroll") for (int k = 0; k < 2; ++k) dst[n][k] = *(const PG8_LAS bf16x8*)(lds + PG8_SB(b, h) + boff + n * 2048 + k * 1024); } while (0)
#define PG8_MMA(ai, bj, At, Bt) do { __builtin_amdgcn_s_setprio(1); _Pragma("unroll") for (int m = 0; m < 4; ++m) _Pragma("unroll") for (int n = 0; n < 2; ++n) _Pragma("unroll") for (int k = 0; k < 2; ++k) \
        acc[ai][bj][m][n] = __builtin_amdgcn_mfma_f32_16x16x32_bf16(Bt[n][k], At[m][k], acc[ai][bj][m][n], 0, 0, 0); __builtin_amdgcn_s_setprio(0); } while (0)
#define PG8_WAIT_V(n) asm volatile("s_waitcnt vmcnt(" #n ")" ::: "memory")
#define PG8_WAIT_L(n) asm volatile("s_waitcnt lgkmcnt(" #n ")" ::: "memory")
#define PG8_BAR __builtin_amdgcn_s_barrier()
#define PG8_SCHED __builtin_amdgcn_sched_barrier(0)
    Unit cur, nxt; int ui = 0;
    if (!S.next(0, cur)) return;
    f32x4 acc[2][2][4][2];
#pragma unroll
    for (int a = 0; a < 2; ++a)
#pragma unroll
        for (int b = 0; b < 2; ++b)
#pragma unroll
            for (int m = 0; m < 4; ++m)
#pragma unroll
                for (int n = 0; n < 2; ++n) acc[a][b][m][n] = (f32x4){0.f, 0.f, 0.f, 0.f};
    bf16x8 At[4][2], B0[2][2], B1[2][2];
    const char* cA = (const char*)g.A + (size_t)cur.pm * tstep; const char* cB = (const char*)g.Bt + (size_t)cur.pn * tstep;
    S.a_ready(cur);
    if constexpr (SP2) {
        PG8_STAGE(PG8_SB(0, 0), cB, voffB); PG8_STAGE(PG8_SB(0, 1), cB + hstep, voffB); PG8_STAGE(PG8_SA(0, 0), cA, voffA); PG8_STAGE(PG8_SA(0, 1), cA + hstep, voffA);
        if (wr == 1) PG8_BAR;
        PG8_WAIT_V(2); PG8_BAR;
        PG8_STAGE(PG8_SB(1, 0), cB + kstep, voffB); PG8_STAGE(PG8_SA(1, 0), cA + kstep, voffA); PG8_STAGE(PG8_SB(1, 1), cB + hstep + kstep, voffB);
        PG8_WAIT_V(6); PG8_BAR;
    } else {
        PG8_STAGE(PG8_SB(0, 0), cB, voffB); PG8_STAGE(PG8_SA(0, 0), cA, voffA); PG8_STAGE(PG8_SB(0, 1), cB + hstep, voffB); PG8_STAGE(PG8_SA(0, 1), cA + hstep, voffA);
        if (wr == 1) PG8_BAR;
        PG8_WAIT_V(4); PG8_BAR;
        PG8_STAGE(PG8_SB(1, 0), cB + kstep, voffB); PG8_STAGE(PG8_SA(1, 0), cA + kstep, voffA); PG8_STAGE(PG8_SB(1, 1), cB + hstep + kstep, voffB);
        PG8_WAIT_V(6); PG8_BAR;
    }
    for (;;) {
        const bool has_next = S.next(ui + 1, nxt);
        const char* nA = has_next ? (const char*)g.A + (size_t)nxt.pm * tstep : cA; const char* nB = has_next ? (const char*)g.Bt + (size_t)nxt.pn * tstep : cB;
        for (int t = 0; t < nt; t += 2) {
            const bool last = (t == nt - 2);
            const char* a1 = cA + (size_t)(t + 1) * kstep;
            const char* a2 = last ? nA : cA + (size_t)(t + 2) * kstep; const char* b2 = last ? nB : cB + (size_t)(t + 2) * kstep;
            const char* a3 = a2 + kstep; const char* b3 = b2 + kstep;
            if (last && has_next) S.a_ready(nxt);
            if constexpr (SP2) {
            PG8_LDB(B0, 0, 0); PG8_LDB(B1, 0, 1); PG8_SCHED; PG8_LDA(At, 0, 0); PG8_STAGE(PG8_SA(1, 1), a1 + hstep, voffA);
            PG8_WAIT_V(8); PG8_WAIT_L(0); PG8_BAR; PG8_MMA(0, 0, At, B0); PG8_MMA(0, 1, At, B1); PG8_BAR; PG8_SCHED;
            PG8_LDA(At, 0, 1); PG8_STAGE(PG8_SB(0, 0), b2, voffB); PG8_STAGE(PG8_SB(0, 1), b2 + hstep, voffB); PG8_STAGE(PG8_SA(0, 0), a2, voffA);
            PG8_WAIT_V(8); PG8_WAIT_L(0); PG8_BAR; PG8_MMA(1, 0, At, B0); PG8_MMA(1, 1, At, B1); PG8_BAR; PG8_SCHED;
            PG8_LDB(B0, 1, 0); PG8_LDB(B1, 1, 1); PG8_SCHED; PG8_LDA(At, 1, 0); PG8_STAGE(PG8_SA(0, 1), a2 + hstep, voffA);
            PG8_WAIT_V(8); PG8_WAIT_L(0); PG8_BAR; PG8_MMA(0, 0, At, B0); PG8_MMA(0, 1, At, B1); PG8_BAR; PG8_SCHED;
            PG8_LDA(At, 1, 1); PG8_STAGE(PG8_SB(1, 0), b3, voffB); PG8_STAGE(PG8_SB(1, 1), b3 + hstep, voffB); PG8_STAGE(PG8_SA(1, 0), a3, voffA);
            PG8_WAIT_V(8); PG8_WAIT_L(0); PG8_BAR; PG8_MMA(1, 0, At, B0); PG8_MMA(1, 1, At, B1); PG8_BAR; PG8_SCHED;
            } else {
            PG8_LDB(B0, 0, 0); PG8_SCHED; PG8_LDA(At, 0, 0); PG8_STAGE(PG8_SA(1, 1), a1 + hstep, voffA);
            PG8_WAIT_L(8); PG8_BAR; PG8_WAIT_L(0); PG8_MMA(0, 0, At, B0); PG8_BAR; PG8_SCHED;
            PG8_LDB(B1, 0, 1); PG8_STAGE(PG8_SB(0, 0), b2, voffB);
            PG8_BAR; PG8_WAIT_L(0); PG8_MMA(0, 1, At, B1); PG8_BAR;
            PG8_LDA(At, 0, 1); PG8_STAGE(PG8_SA(0, 0), a2, voffA);
            PG8_BAR; PG8_WAIT_L(0); PG8_MMA(1, 0, At, B0); PG8_BAR; PG8_SCHED;
            PG8_STAGE(PG8_SB(0, 1), b2 + hstep, voffB);
            PG8_WAIT_V(6); PG8_BAR; PG8_MMA(1, 1, At, B1); PG8_BAR;
            PG8_LDB(B0, 1, 0); PG8_SCHED; PG8_LDA(At, 1, 0); PG8_STAGE(PG8_SA(0, 1), a2 + hstep, voffA);
            PG8_WAIT_L(8); PG8_BAR; PG8_WAIT_L(0); PG8_MMA(0, 0, At, B0); PG8_BAR; PG8_SCHED;
            PG8_LDB(B1, 1, 1); PG8_STAGE(PG8_SB(1, 0), b3, voffB);
            PG8_BAR; PG8_WAIT_L(0); PG8_MMA(0, 1, At, B1); PG8_BAR;
            PG8_LDA(At, 1, 1); PG8_STAGE(PG8_SA(1, 0), a3, voffA);
            PG8_BAR; PG8_WAIT_L(0); PG8_MMA(1, 0, At, B0); PG8_BAR; PG8_SCHED;
            PG8_STAGE(PG8_SB(1, 1), b3 + hstep, voffB);
            PG8_WAIT_V(6); PG8_BAR; PG8_MMA(1, 1, At, B1); PG8_BAR;
            }
        }
        if constexpr (ALIGN_EPI) { if (wr == 0) PG8_BAR; }
        if constexpr (!Epi::AFTER_DRAIN) { E(acc, cur, wr, wc, fr, fq); S.done(cur); }
        if (!has_next) break;
#pragma unroll
        for (int a = 0; a < 2; ++a)
#pragma unroll
            for (int b = 0; b < 2; ++b)
#pragma unroll
                for (int m = 0; m < 4; ++m)
#pragma unroll
                    for (int n = 0; n < 2; ++n) acc[a][b][m][n] = (f32x4){0.f, 0.f, 0.f, 0.f};
        cur = nxt; cA = nA; cB = nB; ++ui;
        if constexpr (ALIGN_EPI) { if (wr == 1) PG8_BAR; }
    }
    PG8_WAIT_V(0);
    if constexpr (!ALIGN_EPI) { if (wr == 0) PG8_BAR; }
    PG8_BAR;
    if constexpr (Epi::AFTER_DRAIN) { E.fused(acc, cur, wr, wc, fr, fq, lds, wid, lane); S.done(cur); }
#undef PG8_SA
#undef PG8_SB
#undef PG8_STAGE
#undef PG8_LDA
#undef PG8_LDB
#undef PG8_MMA
#undef PG8_WAIT_V
#undef PG8_WAIT_L
#undef PG8_BAR
#undef PG8_SCHED
}
}

namespace cg = cooperative_groups;
namespace mk {
using pg8::bf16_t; using pg8::bf16x8; using pg8::f32x4; using pg8::u32x4;
typedef unsigned u32x2 __attribute__((ext_vector_type(2)));
typedef short bf16x4 __attribute__((ext_vector_type(4)));
#define LAS __attribute__((address_space(3)))

constexpr int BATCH = 2, SEQ = 16384, DM = 1024, M = BATCH * SEQ, FFH = 2816;
constexpr float ALPHA = 1.681792830507429f, EPS = 1e-5f, LOG2E = 1.4426950408889634f;
constexpr size_t MiB = 1u << 20;
constexpr size_t WS_W = 1 * MiB, WS_XN = 33 * MiB, WS_PROJ = 97 * MiB, WS_MIX = 289 * MiB, WS_ST = 417 * MiB, WS_DEC = 481 * MiB, WS_TAB = 481 * MiB + 65536;
constexpr size_t WO_IN = 0, WO_OUT = (size_t)5888 * 1024, WO_GU = WO_OUT + (size_t)1024 * 2048, WO_D = WO_GU + (size_t)5632 * 1024;
constexpr int LDS_BYTES = 147456;

__device__ __forceinline__ float bflo(unsigned w) { return __uint_as_float(w << 16); }
__device__ __forceinline__ float bfhi(unsigned w) { return __uint_as_float(w & 0xffff0000u); }
__device__ __forceinline__ float bf2f(bf16_t v) { return __uint_as_float(((unsigned)v) << 16); }
__device__ __forceinline__ unsigned f2bf(float f) { unsigned u = __float_as_uint(f); return (u + 0x7fffu + ((u >> 16) & 1u)) >> 16; }
__device__ __forceinline__ unsigned pk2(float lo, float hi) { return f2bf(lo) | (f2bf(hi) << 16); }
__device__ __forceinline__ void unpack8(const u32x4 v, float* o) { o[0] = bflo(v.x); o[1] = bfhi(v.x); o[2] = bflo(v.y); o[3] = bfhi(v.y); o[4] = bflo(v.z); o[5] = bfhi(v.z); o[6] = bflo(v.w); o[7] = bfhi(v.w); }
__device__ __forceinline__ u32x4 pack8(const float* o) { u32x4 v; v.x = pk2(o[0], o[1]); v.y = pk2(o[2], o[3]); v.z = pk2(o[4], o[5]); v.w = pk2(o[6], o[7]); return v; }
__device__ __forceinline__ float silu(float x) { return x / (1.0f + __expf(-x)); }
__device__ __forceinline__ float wave_sum(float v) {
#pragma unroll
    for (int o = 1; o < 64; o <<= 1) v += __shfl_xor(v, o);
    return v;
}
__device__ __forceinline__ float wave_scan_incl(float v, int lane) {
#pragma unroll
    for (int o = 1; o < 64; o <<= 1) { const float t = __shfl_up(v, o); if (lane >= o) v += t; }
    return v;
}
__device__ __forceinline__ f32x4 mfma16(bf16x8 a, bf16x8 b, f32x4 c) { return __builtin_amdgcn_mfma_f32_16x16x32_bf16(a, b, c, 0, 0, 0); }
__device__ __forceinline__ bf16x8 cat44(bf16x4 a, bf16x4 b) { return __builtin_shufflevector(a, b, 0, 1, 2, 3, 4, 5, 6, 7); }
__device__ __forceinline__ bf16x8 packf8(f32x4 a, f32x4 b) { u32x4 v; v.x = pk2(a[0], a[1]); v.y = pk2(a[2], a[3]); v.z = pk2(b[0], b[1]); v.w = pk2(b[2], b[3]); return __builtin_bit_cast(bf16x8, v); }
__device__ __forceinline__ void sincos_ang(float ang, float& s, float& c) {
    double t = (double)ang * 0.15915494309189535; t -= rint(t); const float f = (float)t;
    s = __builtin_amdgcn_sinf(f); c = __builtin_amdgcn_cosf(f);
}
__device__ __forceinline__ float log2gamma(int h) { return h == 0 ? -0.04580368961312479f : h == 1 ? -0.02272007650008353f : h == 2 ? -0.011315313227834146f : -0.005646563141142063f; }
__device__ __forceinline__ float softplus(float x) { return x > 20.f ? x : log1pf(__expf(x)); }

#define LAUNDER_V(x) asm volatile("" : "+v"(x))
#define LAUNDER_S(x) asm volatile("" : "+s"(x))
struct Params { const float* in[25]; float* out; unsigned char* ws; };
constexpr int PTR_OFF = LDS_BYTES - 512;
__device__ __forceinline__ unsigned long long ldq(LAS unsigned char* lds, int i) {
    volatile LAS unsigned long long* t = (volatile LAS unsigned long long*)(lds + PTR_OFF); const unsigned long long v = t[i];
    const unsigned lo = __builtin_amdgcn_readfirstlane((unsigned)v), hi = __builtin_amdgcn_readfirstlane((unsigned)(v >> 32));
    return ((unsigned long long)hi << 32) | lo;
}
__device__ __forceinline__ const float* ldin(LAS unsigned char* lds, int i) { return (const float*)ldq(lds, i); }
__device__ __forceinline__ unsigned char* ldws(LAS unsigned char* lds) { return (unsigned char*)ldq(lds, 26); }
__device__ __forceinline__ float* ldout(LAS unsigned char* lds) { return (float*)ldq(lds, 25); }

#define XB_TMO      128
#define XB_XCNT(j)  (256  + 64 * (j))
#define XB_XSUB(j)  (1280 + 64 * (j))
#define XB_XGEN(j)  (2304 + 64 * (j))
#define XB_TOP      3328
#define XB_TOPGEN   3392
#define XCD_BAR_WORDS 3456
#define XB_SPIN_CAP (1u << 18)

__device__ __forceinline__ unsigned xb_ld(unsigned* p)              { return __hip_atomic_load(p, __ATOMIC_RELAXED, __HIP_MEMORY_SCOPE_AGENT); }
__device__ __forceinline__ unsigned xb_add(unsigned* p, unsigned v) { return __hip_atomic_fetch_add(p, v, __ATOMIC_RELAXED, __HIP_MEMORY_SCOPE_AGENT); }
__device__ __forceinline__ unsigned xb_xcc_id() { return (unsigned)__builtin_amdgcn_s_getreg((3 << 11) | 20) & 0xFu; }
#define XB_SPIN(cond, bar) do { unsigned _sp = 0; while (cond) { __builtin_amdgcn_s_sleep(1); \
    if ((++_sp & 255u) == 0u) { if (xb_ld(&(bar)[XB_TMO])) break; if (_sp > XB_SPIN_CAP) { atomicAdd(&(bar)[XB_TMO], 1u); break; } } } } while (0)

struct XcdBarrier {
    unsigned* bar; unsigned x;
    volatile LAS unsigned* st;
};

__device__ __forceinline__ XcdBarrier xcd_barrier_post(unsigned* bar, volatile LAS unsigned* st) {
    XcdBarrier b; b.bar = bar; b.x = xb_xcc_id(); b.st = st;
    if (threadIdx.x == 0) (void)xb_add(&bar[XB_XCNT(b.x)], 1u);
    return b;
}
__device__ __forceinline__ void xcd_barrier_complete(unsigned* bar, unsigned x, unsigned& nloc, unsigned& nx) {
    const unsigned G = gridDim.x * gridDim.y * gridDim.z;
    unsigned sum, cnt, mine, sp = 0u;
    for (;;) {
        sum = 0u; cnt = 0u; mine = 0u;
#pragma unroll
        for (unsigned j = 0; j < 16; ++j) { const unsigned c = xb_ld(&bar[XB_XCNT(j)]); sum += c; cnt += (c > 0u) ? 1u : 0u; mine = (j == x) ? c : mine; }
        if (sum == G) break;
        __builtin_amdgcn_s_sleep(1);
        if ((++sp & 255u) == 0u) { if (xb_ld(&bar[XB_TMO])) break; if (sp > XB_SPIN_CAP) { atomicAdd(&bar[XB_TMO], 1u); break; } }
    }
    nloc = mine > 0u ? mine : 1u; nx = cnt > 0u ? cnt : 1u;
}

__device__ __forceinline__ void xcd_barrier(const XcdBarrier& b) {
    asm volatile("s_waitcnt vmcnt(0)" ::: "memory");
    __syncthreads();
    if (threadIdx.x == 0) {
        unsigned* bar = b.bar;
        __builtin_amdgcn_s_waitcnt(0);
        unsigned nloc = b.st[0], nx = b.st[1];
        if (nloc == 0u) { xcd_barrier_complete(bar, b.x, nloc, nx); b.st[0] = nloc; b.st[1] = nx; }
        const unsigned old = xb_add(&bar[XB_XSUB(b.x)], 1u);
        const unsigned gen = old / nloc;
        if (old + 1u == (gen + 1u) * nloc) {
            __builtin_amdgcn_fence(__ATOMIC_RELEASE, "agent");
            asm volatile("s_waitcnt vmcnt(0)" ::: "memory");
            const unsigned og = xb_add(&bar[XB_TOP], 1u);
            const unsigned tg = og / nx;
            if (og + 1u == (tg + 1u) * nx) xb_add(&bar[XB_TOPGEN], 1u);
            else XB_SPIN(xb_ld(&bar[XB_TOPGEN]) == tg, bar);
            __builtin_amdgcn_fence(__ATOMIC_ACQUIRE, "agent");
            xb_add(&bar[XB_XGEN(b.x)], 1u);
            asm volatile("s_waitcnt vmcnt(0)" ::: "memory");
        } else {
            XB_SPIN(xb_ld(&bar[XB_XGEN(b.x)]) == gen, bar);
            __builtin_amdgcn_fence(__ATOMIC_ACQUIRE, "agent");
            asm volatile("s_waitcnt vmcnt(0)" ::: "memory");
        }
    }
    __syncthreads();
}


__device__ __forceinline__ void tr_item(const float* W, int N, int k0, int nsrc0, bf16_t* WT, int K, int drow0, LAS float* scr, int lane) {
#pragma unroll 8
    for (int i = 0; i < 32; ++i) { const int kk = 2 * i + (lane >> 5); scr[kk * 33 + (lane & 31)] = W[(size_t)(k0 + kk) * N + nsrc0 + (lane & 31)]; }
    asm volatile("s_waitcnt lgkmcnt(0)" ::: "memory");
    const int c = lane & 7;
#pragma unroll
    for (int j = 0; j < 4; ++j) { const int n = (lane >> 3) + 8 * j; const LAS float* s = scr + (8 * c) * 33 + n;
        u32x4 o; o.x = pk2(s[0 * 33], s[1 * 33]); o.y = pk2(s[2 * 33], s[3 * 33]); o.z = pk2(s[4 * 33], s[5 * 33]); o.w = pk2(s[6 * 33], s[7 * 33]);
        *(u32x4*)(WT + (size_t)(drow0 + n) * K + k0 + 8 * c) = o; }
    asm volatile("s_waitcnt lgkmcnt(0)" ::: "memory");
}
__device__ __forceinline__ void convert_layer(int L, LAS unsigned char* lds, int gw, int NGW, int lane, int wave, int gtid, int nthr) {
    LAUNDER_V(lane); LAUNDER_S(wave); LAUNDER_S(gw); LAUNDER_V(gtid);
    bf16_t* Wb = (bf16_t*)(ldws(lds) + WS_W);
    LAS float* scr = (LAS float*)(lds + wave * 16384);
    const int e = L >> 1; const bool odd = (L & 1) != 0;
    const int cIN = odd ? (16 * 80 + 16 * 96) : 16 * 56, cOUT = odd ? 32 * 32 : 16 * 32, cG = 16 * 88, cD = 44 * 32;
    const int total = cIN + cOUT + 2 * cG + cD;
    for (int it = gw; it < total; it += NGW) {
        int r = it; const float* W; int N, k0, nsrc0, K, drow0; bf16_t* WT;
        if (r < cIN) {
            WT = Wb + WO_IN; K = 1024;
            if (!odd) { const int nb = r % 56, kb = r / 56; W = ldin(lds, 8) + (size_t)e * 1024 * 1792; N = 1792; k0 = kb * 64; nsrc0 = nb * 32; drow0 = nb * 32; }
            else if (r < 1280) { const int nb = r % 80, kb = r / 80; W = ldin(lds, 15) + (size_t)e * 1024 * 5648; N = 5648; k0 = kb * 64; nsrc0 = nb * 32; drow0 = nb * 32; }
            else { const int r2 = r - 1280; const int nb = r2 % 96, kb = r2 / 96; W = ldin(lds, 15) + (size_t)e * 1024 * 5648; N = 5648; k0 = kb * 64; nsrc0 = 2576 + nb * 32; drow0 = 2816 + nb * 32; }
        } else if ((r -= cIN) < cOUT) {
            WT = Wb + WO_OUT; const int nb = r % 32, kb = r / 32; N = 1024; k0 = kb * 64; nsrc0 = nb * 32; drow0 = nb * 32;
            if (!odd) { W = ldin(lds, 14) + (size_t)e * 1024 * 1024; K = 1024; } else { W = ldin(lds, 24) + (size_t)e * 2048 * 1024; K = 2048; }
        } else if ((r -= cOUT) < 2 * cG) {
            const int up = r >= cG ? 1 : 0; if (up) r -= cG;
            WT = Wb + WO_GU; K = 1024; const int nb = r % 88, kb = r / 88; const int j0 = nb * 32;
            W = ldin(lds, up ? 6 : 5) + (size_t)L * 1024 * 2816; N = 2816; k0 = kb * 64; nsrc0 = j0; drow0 = (j0 >> 7) * 256 + (j0 & 127) + up * 128;
        } else {
            r -= 2 * cG; WT = Wb + WO_D; K = 2816; const int nb = r % 32, kb = r / 32;
            W = ldin(lds, 7) + (size_t)L * 2816 * 1024; N = 1024; k0 = kb * 64; nsrc0 = nb * 32; drow0 = nb * 32;
        }
        tr_item(W, N, k0, nsrc0, WT, K, drow0, scr, lane);
    }
    if (odd) {
        const float* W = ldin(lds, 15) + (size_t)e * 1024 * 5648; bf16_t* WT = Wb + WO_IN;
        for (int idx = gtid; idx < 16 * 1024; idx += nthr) { const int n = idx >> 10, k = idx & 1023; WT[(size_t)(2560 + n) * 1024 + k] = (bf16_t)f2bf(W[(size_t)k * 5648 + 2560 + n]); }
        unsigned* z = (unsigned*)(WT + (size_t)2576 * 1024);
        for (int idx = gtid; idx < 240 * 512; idx += nthr) z[idx] = 0u;
    }
}

__device__ __forceinline__ void ln_phase(float* X, bf16_t* XN, const float* g, const float* b, int gw, int NGW, int lane) {
    LAUNDER_V(lane); LAUNDER_S(gw);
    for (int m = gw; m < M; m += NGW) {
        float* xr = X + (size_t)m * DM + lane * 4;
        f32x4 v[4]; float s = 0.f;
#pragma unroll
        for (int j = 0; j < 4; ++j) { v[j] = *(const f32x4*)(xr + j * 256); s += (v[j][0] + v[j][1]) + (v[j][2] + v[j][3]); }
        const float mean = wave_sum(s) * (1.f / DM); float q = 0.f;
#pragma unroll
        for (int j = 0; j < 4; ++j) { v[j] = v[j] - mean; q += (v[j][0] * v[j][0] + v[j][1] * v[j][1]) + (v[j][2] * v[j][2] + v[j][3] * v[j][3]); }
        const float rstd = 1.0f / sqrtf(wave_sum(q) * (1.f / DM) + EPS);
#pragma unroll
        for (int j = 0; j < 4; ++j) { const f32x4 gg = *(const f32x4*)(g + j * 256 + lane * 4), bb = *(const f32x4*)(b + j * 256 + lane * 4);
            const f32x4 y = v[j] * rstd * gg + bb; *(f32x4*)(xr + j * 256) = y;
            u32x2 w; w.x = pk2(y[0], y[1]); w.y = pk2(y[2], y[3]); *(u32x2*)(XN + (size_t)m * DM + j * 256 + lane * 4) = w; }
    }
}

__device__ __forceinline__ void rope16(u32x4& a, u32x4& c, float pos, const float* inv) {
    float x1[8], x2[8], o1[8], o2[8]; unpack8(a, x1); unpack8(c, x2);
#pragma unroll
    for (int e = 0; e < 8; ++e) { float s, co; sincos_ang(pos * inv[e], s, co); o1[e] = x1[e] * co - x2[e] * s; o2[e] = x2[e] * co + x1[e] * s; }
    a = pack8(o1); c = pack8(o2);
}
__device__ __forceinline__ void attn_unit(LAS unsigned char* lds, const bf16_t* PR, bf16_t* MIX, const float* sinks, const float* inv_att, int b, int n, int j, int tid, int lane, int wave) {
    LAUNDER_V(tid); LAUNDER_V(lane); LAUNDER_S(wave);
    constexpr int QS = 72, VS = 264;
    LAS bf16_t* Qs = (LAS bf16_t*)lds;
    LAS bf16_t* Ks = (LAS bf16_t*)(lds + 73728);
    LAS bf16_t* Vt = (LAS bf16_t*)(lds + 73728 + 36864);
    const size_t R0 = (size_t)b * SEQ + (size_t)n * 128;
#pragma unroll 1
    for (int it = 0; it < 4; ++it) { const int idx = tid + it * 512; const int cp = idx & 3, i = (idx >> 2) & 127, g = idx >> 9;
        const bf16_t* src = PR + (R0 + i) * 1792 + (j * 4 + g) * 64 + cp * 16;
        u32x4 a = *(const u32x4*)src, c = *(const u32x4*)(src + 8);
        if (cp == 0) rope16(a, c, (float)(n * 128 + i), inv_att);
        LAS bf16_t* dst = Qs + (g * 128 + i) * QS + cp * 16; *(LAS u32x4*)dst = a; *(LAS u32x4*)(dst + 8) = c; }
#pragma unroll 1
    for (int it = 0; it < 2; ++it) { const int idx = tid + it * 512; const int cp = idx & 3, jj = idx >> 2;
        u32x4 a = (u32x4){0u, 0u, 0u, 0u}, c = a;
        if (n > 0 || jj >= 128) { const bf16_t* src = PR + (R0 + jj - 128) * 1792 + 512 + j * 64 + cp * 16; a = *(const u32x4*)src; c = *(const u32x4*)(src + 8);
            if (cp == 0) rope16(a, c, (float)(n * 128 - 128 + jj), inv_att); }
        LAS bf16_t* dst = Ks + jj * QS + cp * 16; *(LAS u32x4*)dst = a; *(LAS u32x4*)(dst + 8) = c; }
#pragma unroll 1
    for (int it = 0; it < 4; ++it) { const int idx = tid + it * 512; const int jj = idx & 255, c8 = idx >> 8;
        u32x4 a = (u32x4){0u, 0u, 0u, 0u};
        if (n > 0 || jj >= 128) a = *(const u32x4*)(PR + (R0 + jj - 128) * 1792 + 640 + j * 64 + c8 * 8);
        LAS bf16_t* dst = Vt + (c8 * 8) * VS + jj;
        dst[0 * VS] = (bf16_t)(a.x & 0xffffu); dst[1 * VS] = (bf16_t)(a.x >> 16); dst[2 * VS] = (bf16_t)(a.y & 0xffffu); dst[3 * VS] = (bf16_t)(a.y >> 16);
        dst[4 * VS] = (bf16_t)(a.z & 0xffffu); dst[5 * VS] = (bf16_t)(a.z >> 16); dst[6 * VS] = (bf16_t)(a.w & 0xffffu); dst[7 * VS] = (bf16_t)(a.w >> 16); }
    __syncthreads();
    const int fr = lane & 15, fq = lane >> 4; const int g = wave >> 1, half = (wave & 1) * 64;
    const float sink = sinks[j * 4 + g] * LOG2E; const float SC = 0.125f * LOG2E;
#pragma unroll 1
    for (int qt = 0; qt < 4; ++qt) {
        const int i0 = half + qt * 16, klo = i0 & ~31, i = i0 + fr;
        const LAS bf16_t* qp = Qs + (g * 128 + i0 + fr) * QS + fq * 8;
        const bf16x8 qf0 = *(const LAS bf16x8*)qp, qf1 = *(const LAS bf16x8*)(qp + 32);
        f32x4 s[10];
#pragma unroll
        for (int t = 0; t < 10; ++t) { const LAS bf16_t* kp = Ks + (klo + t * 16 + fr) * QS + fq * 8;
            const bf16x8 k0 = *(const LAS bf16x8*)kp, k1 = *(const LAS bf16x8*)(kp + 32);
            s[t] = mfma16(k0, qf0, (f32x4){0.f, 0.f, 0.f, 0.f}); s[t] = mfma16(k1, qf1, s[t]); }
        float mx = sink;
#pragma unroll
        for (int t = 0; t < 10; ++t)
#pragma unroll
            for (int r = 0; r < 4; ++r) { const int jj = klo + t * 16 + fq * 4 + r; const bool valid = (jj > i) && (jj <= i + 128) && (n > 0 || jj >= 128);
                const float v = valid ? s[t][r] * SC : -INFINITY; s[t][r] = v; mx = fmaxf(mx, v); }
        mx = fmaxf(mx, __shfl_xor(mx, 16)); mx = fmaxf(mx, __shfl_xor(mx, 32));
        float l = 0.f;
#pragma unroll
        for (int t = 0; t < 10; ++t)
#pragma unroll
            for (int r = 0; r < 4; ++r) { const float p = exp2f(s[t][r] - mx); s[t][r] = p; l += p; }
        l += __shfl_xor(l, 16); l += __shfl_xor(l, 32); l += exp2f(sink - mx);
        const float linv = 1.0f / l;
        bf16x8 pf[5];
#pragma unroll
        for (int ks = 0; ks < 5; ++ks) pf[ks] = packf8(s[2 * ks], s[2 * ks + 1]);
#pragma unroll
        for (int nt = 0; nt < 4; ++nt) { f32x4 o = (f32x4){0.f, 0.f, 0.f, 0.f};
#pragma unroll
            for (int ks = 0; ks < 5; ++ks) { const LAS bf16_t* vp = Vt + (nt * 16 + fr) * VS + klo + ks * 32 + fq * 4;
                const bf16x8 vf = cat44(*(const LAS bf16x4*)vp, *(const LAS bf16x4*)(vp + 16)); o = mfma16(vf, pf[ks], o); }
            u32x2 w; w.x = pk2(o[0] * linv, o[1] * linv); w.y = pk2(o[2] * linv, o[3] * linv);
            *(u32x2*)(MIX + (R0 + i0 + fr) * 1024 + (j * 4 + g) * 64 + nt * 16 + fq * 4) = w; }
    }
    __syncthreads();
}
__device__ __forceinline__ void conv_unit(LAS unsigned char* lds, const bf16_t* PR, bf16_t* MIX, const float* dw_w, const float* dw_b, const float* cn_g, const float* cn_b, int b, int tb, int tid, int lane, int wave) {
    LAUNDER_V(tid); LAUNDER_V(lane); LAUNDER_S(wave);
    LAS float* hs = (LAS float*)lds;
    const int t0 = tb * 32; const size_t Rb = (size_t)b * SEQ;
#pragma unroll 1
    for (int idx = tid; idx < 62 * 64; idx += 512) { const int c8 = idx & 63, r = idx >> 6; const int t = t0 - 30 + r;
        float h[8];
#pragma unroll
        for (int e = 0; e < 8; ++e) h[e] = 0.f;
        if (t >= 0) { const bf16_t* src = PR + (Rb + t) * 1792 + 768 + c8 * 8; const u32x4 av = *(const u32x4*)src, gv = *(const u32x4*)(src + 512);
            float a[8], gt[8]; unpack8(av, a); unpack8(gv, gt);
#pragma unroll
            for (int e = 0; e < 8; ++e) h[e] = a[e] / (1.0f + __expf(-gt[e])); }
        LAS float* dst = hs + r * 512 + c8 * 8; *(LAS f32x4*)dst = (f32x4){h[0], h[1], h[2], h[3]}; *(LAS f32x4*)(dst + 4) = (f32x4){h[4], h[5], h[6], h[7]}; }
    __syncthreads();
    { const int c = tid; float w[31];
#pragma unroll
        for (int k = 0; k < 31; ++k) w[k] = dw_w[k * 512 + c];
        const float bias = dw_b[c];
#pragma unroll 1
        for (int tt = 0; tt < 32; ++tt) { float acc = bias;
#pragma unroll
            for (int k = 0; k < 31; ++k) acc += w[k] * hs[(tt + k) * 512 + c];
            hs[tt * 512 + c] = acc; } }
    __syncthreads();
#pragma unroll 1
    for (int q = 0; q < 4; ++q) { const int tt = wave * 4 + q;
        const f32x4 v0 = *(const LAS f32x4*)(hs + tt * 512 + lane * 8), v1 = *(const LAS f32x4*)(hs + tt * 512 + lane * 8 + 4);
        float s = (v0[0] + v0[1]) + (v0[2] + v0[3]) + (v1[0] + v1[1]) + (v1[2] + v1[3]);
        const float mean = wave_sum(s) * (1.f / 512.f);
        const f32x4 d0 = v0 - mean, d1 = v1 - mean;
        float qv = (d0[0] * d0[0] + d0[1] * d0[1]) + (d0[2] * d0[2] + d0[3] * d0[3]) + (d1[0] * d1[0] + d1[1] * d1[1]) + (d1[2] * d1[2] + d1[3] * d1[3]);
        const float rstd = 1.0f / sqrtf(wave_sum(qv) * (1.f / 512.f) + EPS);
        const f32x4 g0 = *(const f32x4*)(cn_g + lane * 8), g1 = *(const f32x4*)(cn_g + lane * 8 + 4), b0 = *(const f32x4*)(cn_b + lane * 8), b1 = *(const f32x4*)(cn_b + lane * 8 + 4);
        const f32x4 y0 = d0 * rstd * g0 + b0, y1 = d1 * rstd * g1 + b1;
        u32x4 w; w.x = pk2(silu(y0[0]), silu(y0[1])); w.y = pk2(silu(y0[2]), silu(y0[3])); w.z = pk2(silu(y1[0]), silu(y1[1])); w.w = pk2(silu(y1[2]), silu(y1[3]));
        *(u32x4*)(MIX + (Rb + t0 + tt) * 1024 + 512 + lane * 8) = w; }
    __syncthreads();
}

__device__ __forceinline__ void xbc_conv8(const bf16_t* PA, size_t grow, int t, int col, const float* cw, const float* cb, int cch, float* out) {
    const f32x4 b0 = *(const f32x4*)(cb + cch), b1 = *(const f32x4*)(cb + cch + 4);
    float acc[8] = {b0[0], b0[1], b0[2], b0[3], b1[0], b1[1], b1[2], b1[3]};
#pragma unroll
    for (int k = 0; k < 4; ++k) { const int tt = t - 3 + k;
        if (tt >= 0) { const u32x4 v = *(const u32x4*)(PA + (grow + k - 3) * 2816 + col); float x[8]; unpack8(v, x);
            const f32x4 w0 = *(const f32x4*)(cw + k * 1536 + cch), w1 = *(const f32x4*)(cw + k * 1536 + cch + 4);
            acc[0] += w0[0] * x[0]; acc[1] += w0[1] * x[1]; acc[2] += w0[2] * x[2]; acc[3] += w0[3] * x[3];
            acc[4] += w1[0] * x[4]; acc[5] += w1[1] * x[5]; acc[6] += w1[2] * x[6]; acc[7] += w1[3] * x[7]; } }
#pragma unroll
    for (int e = 0; e < 8; ++e) out[e] = silu(acc[e]);
}
__device__ __forceinline__ void xbc_conv8x2(const bf16_t* PA, size_t grow, int t, int col, const float* cw, const float* cb, int cch, float* o0, float* o1) {
    const f32x4 b0 = *(const f32x4*)(cb + cch), b1 = *(const f32x4*)(cb + cch + 4);
    float a0[8] = {b0[0], b0[1], b0[2], b0[3], b1[0], b1[1], b1[2], b1[3]}, a1[8] = {b0[0], b0[1], b0[2], b0[3], b1[0], b1[1], b1[2], b1[3]};
    float w[4][8];
#pragma unroll
    for (int k = 0; k < 4; ++k) { const f32x4 w0 = *(const f32x4*)(cw + k * 1536 + cch), w1 = *(const f32x4*)(cw + k * 1536 + cch + 4);
        w[k][0] = w0[0]; w[k][1] = w0[1]; w[k][2] = w0[2]; w[k][3] = w0[3]; w[k][4] = w1[0]; w[k][5] = w1[1]; w[k][6] = w1[2]; w[k][7] = w1[3]; }
#pragma unroll
    for (int kk = 0; kk < 5; ++kk) { const int tt = t - 3 + kk;
        if (tt >= 0) { const u32x4 v = *(const u32x4*)(PA + (grow + kk - 3) * 2816 + col); float x[8]; unpack8(v, x);
#pragma unroll
            for (int e = 0; e < 8; ++e) { if (kk <= 3) a0[e] += w[kk <= 3 ? kk : 0][e] * x[e]; if (kk >= 1) a1[e] += w[kk >= 1 ? kk - 1 : 0][e] * x[e]; } } }
#pragma unroll
    for (int e = 0; e < 8; ++e) { o0[e] = silu(a0[e]); o1[e] = silu(a1[e]); }
}
__device__ __forceinline__ void ssd_local_unit(LAS unsigned char* lds, const bf16_t* PA, bf16_t* ST, float* DEC, const float* cw, const float* cb, const float* dt_bias, const float* a_log,
                                               int b, int c, int g, int tid, int lane, int wave) {
    LAUNDER_V(tid); LAUNDER_V(lane); LAUNDER_S(wave);
    constexpr int RS = 136;
    LAS bf16_t* BT = (LAS bf16_t*)lds;
    LAS bf16_t* XT = (LAS bf16_t*)(lds + 34816);
    LAS float* dts = (LAS float*)(lds + 52224); LAS float* acs = (LAS float*)(lds + 56320); LAS float* tmp = (LAS float*)(lds + 60416);
    const size_t row0 = (size_t)b * SEQ + (size_t)c * 128; const int t0 = c * 128;
#pragma unroll 1
    for (int it = 0; it < 2; ++it) { const int idx = tid + it * 512; const int hg = idx >> 7, l = idx & 127, h = g * 8 + hg;
        const float raw = bf2f(PA[(row0 + l) * 2816 + 2560 + h]) + dt_bias[h]; const float dt = softplus(raw); dts[idx] = dt;
        const float v = wave_scan_incl(-dt * __expf(a_log[h]), lane); acs[idx] = v; if (l == 63) tmp[hg] = v; }
#pragma unroll 1
    for (int it = 0; it < 2; ++it) { const int idx = tid + it * 512; const int l2 = idx & 63, nc = idx >> 6; float v0[8], v1[8];
        xbc_conv8x2(PA, row0 + 2 * l2, t0 + 2 * l2, 2048 + g * 128 + nc * 8, cw, cb, 1024 + g * 128 + nc * 8, v0, v1);
#pragma unroll
        for (int e = 0; e < 8; ++e) *(LAS unsigned*)(BT + (nc * 8 + e) * RS + 2 * l2) = pk2(v0[e], v1[e]); }
    __syncthreads();
#pragma unroll 1
    for (int it = 0; it < 2; ++it) { const int idx = tid + it * 512; if ((idx & 127) >= 64) acs[idx] += tmp[idx >> 7]; }
    __syncthreads();
    const int fr = lane & 15, fq = lane >> 4;
#pragma unroll 1
    for (int hg = 0; hg < 8; ++hg) {
        const int h = g * 8 + hg; const float total = acs[hg * 128 + 127];
        { const int l2 = tid & 63, pc = tid >> 6; float v0[8], v1[8];
            xbc_conv8x2(PA, row0 + 2 * l2, t0 + 2 * l2, 1024 + h * 64 + pc * 8, cw, cb, h * 64 + pc * 8, v0, v1);
            const float f0 = dts[hg * 128 + 2 * l2] * __expf(total - acs[hg * 128 + 2 * l2]), f1 = dts[hg * 128 + 2 * l2 + 1] * __expf(total - acs[hg * 128 + 2 * l2 + 1]);
#pragma unroll
            for (int e = 0; e < 8; ++e) *(LAS unsigned*)(XT + (pc * 8 + e) * RS + 2 * l2) = pk2(v0[e] * f0, v1[e] * f1); }
        __syncthreads();
        f32x4 acc[4];
#pragma unroll
        for (int pt = 0; pt < 4; ++pt) acc[pt] = (f32x4){0.f, 0.f, 0.f, 0.f};
#pragma unroll
        for (int ks = 0; ks < 4; ++ks) { const bf16x8 bfg = *(const LAS bf16x8*)(BT + (wave * 16 + fr) * RS + ks * 32 + fq * 8);
#pragma unroll
            for (int pt = 0; pt < 4; ++pt) { const bf16x8 xf = *(const LAS bf16x8*)(XT + (pt * 16 + fr) * RS + ks * 32 + fq * 8); acc[pt] = mfma16(bfg, xf, acc[pt]); } }
        bf16_t* dst = ST + ((size_t)((b * 128 + c) * 16 + h)) * 8192;
#pragma unroll
        for (int pt = 0; pt < 4; ++pt) { u32x2 w; w.x = pk2(acc[pt][0], acc[pt][1]); w.y = pk2(acc[pt][2], acc[pt][3]); *(u32x2*)(dst + (pt * 16 + fr) * 128 + wave * 16 + fq * 4) = w; }
        if (tid == 0) DEC[(b * 128 + c) * 16 + h] = __expf(total);
        __syncthreads();
    }
}
__device__ __forceinline__ void scan_phase(bf16_t* ST, const float* DEC, int mode, int gtid, int nthr) {
    LAUNDER_V(gtid);
    for (int e2 = gtid; e2 < 131072; e2 += nthr) {
        const int b = e2 >> 16, eb = e2 & 65535; const int h = mode ? (eb >> 14) : (eb >> 12);
        unsigned* p = (unsigned*)ST + (size_t)b * 128 * 65536 + eb;
        const float dconst = exp2f(128.f * log2gamma(h & 3));
        const float* dp = DEC + b * 128 * 16 + (h & 15);
        float c0 = 0.f, c1 = 0.f;
#pragma unroll 1
        for (int c = 0; c < 128; c += 8) { unsigned v[8]; float d[8];
#pragma unroll
            for (int k = 0; k < 8; ++k) { v[k] = p[(size_t)(c + k) * 65536]; d[k] = mode ? dconst : dp[(c + k) * 16]; }
#pragma unroll
            for (int k = 0; k < 8; ++k) { p[(size_t)(c + k) * 65536] = pk2(c0, c1); c0 = c0 * d[k] + bflo(v[k]); c1 = c1 * d[k] + bfhi(v[k]); } }
    }
}
__device__ __forceinline__ void ssd_out_unit(LAS unsigned char* lds, const bf16_t* PA, const bf16_t* ST, bf16_t* MIX, const float* cw, const float* cb, const float* dt_bias, const float* a_log,
                                             const float* d_skip, const float* norm_g, int b, int c, int g, int tid, int lane, int wave) {
    LAUNDER_V(tid); LAUNDER_V(lane); LAUNDER_S(wave);
    constexpr int RS = 136, XR = 72;
    LAS bf16_t* Cs = (LAS bf16_t*)lds;
    LAS bf16_t* Bs = (LAS bf16_t*)(lds + 34816);
    LAS bf16_t* XT = (LAS bf16_t*)(lds + 69632);
    LAS bf16_t* PV = (LAS bf16_t*)(lds + 87040);
    LAS bf16_t* XS = (LAS bf16_t*)(lds + 104448);
    LAS float* dts = (LAS float*)(lds + 122880);
    LAS float* acs = (LAS float*)(lds + 126976);
    LAS float* tmp = (LAS float*)(lds + 69632);
    const size_t row0 = (size_t)b * SEQ + (size_t)c * 128; const int t0 = c * 128;
#pragma unroll 1
    for (int it = 0; it < 2; ++it) { const int idx = tid + it * 512; const int hg = idx >> 7, l = idx & 127, h = g * 8 + hg;
        const float raw = bf2f(PA[(row0 + l) * 2816 + 2560 + h]) + dt_bias[h]; const float dt = softplus(raw); dts[idx] = dt;
        const float v = wave_scan_incl(-dt * __expf(a_log[h]), lane); acs[idx] = v; if (l == 63) tmp[hg] = v; }
    __syncthreads();
#pragma unroll 1
    for (int it = 0; it < 2; ++it) { const int idx = tid + it * 512; if ((idx & 127) >= 64) acs[idx] += tmp[idx >> 7]; }
#pragma unroll 1
    for (int it = 0; it < 2; ++it) { const int idx = tid + it * 512; const int nc = idx & 15, l2 = idx >> 4; float v0[8], v1[8];
        xbc_conv8x2(PA, row0 + 2 * l2, t0 + 2 * l2, 2304 + g * 128 + nc * 8, cw, cb, 1280 + g * 128 + nc * 8, v0, v1); *(LAS u32x4*)(Cs + (2 * l2) * RS + nc * 8) = pack8(v0); *(LAS u32x4*)(Cs + (2 * l2 + 1) * RS + nc * 8) = pack8(v1);
        xbc_conv8x2(PA, row0 + 2 * l2, t0 + 2 * l2, 2048 + g * 128 + nc * 8, cw, cb, 1024 + g * 128 + nc * 8, v0, v1); *(LAS u32x4*)(Bs + (2 * l2) * RS + nc * 8) = pack8(v0); *(LAS u32x4*)(Bs + (2 * l2 + 1) * RS + nc * 8) = pack8(v1); }
    __syncthreads();
    const int fr = lane & 15, fq = lane >> 4; const int l = wave * 16 + fr; const int wodd = wave | 1, nk2 = wave >> 1;
    f32x4 cbt[8];
#pragma unroll
    for (int st = 0; st < 8; ++st) { cbt[st] = (f32x4){0.f, 0.f, 0.f, 0.f};
        if (st <= wodd) {
#pragma unroll
            for (int ks = 0; ks < 4; ++ks) { const bf16x8 af = *(const LAS bf16x8*)(Bs + (st * 16 + fr) * RS + ks * 32 + fq * 8), bf = *(const LAS bf16x8*)(Cs + l * RS + ks * 32 + fq * 8);
                cbt[st] = mfma16(af, bf, cbt[st]); } } }
    float ssq = 0.f;
#pragma unroll 1
    for (int hg = 0; hg < 8; ++hg) {
        const int h = g * 8 + hg;
        __syncthreads();
        { const int l2 = tid & 63, pc = tid >> 6; float v0[8], v1[8];
            xbc_conv8x2(PA, row0 + 2 * l2, t0 + 2 * l2, 1024 + h * 64 + pc * 8, cw, cb, h * 64 + pc * 8, v0, v1);
            *(LAS u32x4*)(XS + (2 * l2) * XR + pc * 8) = pack8(v0); *(LAS u32x4*)(XS + (2 * l2 + 1) * XR + pc * 8) = pack8(v1);
            const float d0 = dts[hg * 128 + 2 * l2], d1 = dts[hg * 128 + 2 * l2 + 1];
#pragma unroll
            for (int e = 0; e < 8; ++e) *(LAS unsigned*)(XT + (pc * 8 + e) * RS + 2 * l2) = pk2(v0[e] * d0, v1[e] * d1); }
        { const bf16_t* src = ST + ((size_t)((b * 128 + c) * 16 + h)) * 8192;
#pragma unroll 1
            for (int it = 0; it < 2; ++it) { const int idx = tid + it * 512; const int nc = idx & 15, p = idx >> 4; *(LAS u32x4*)(PV + p * RS + nc * 8) = *(const u32x4*)(src + p * 128 + nc * 8); } }
        __syncthreads();
        int lc = l; LAUNDER_V(lc);
        const LAS float* ah = acs + hg * 128; const float al = ah[l];
        f32x4 accd[4], acco[4];
#pragma unroll
        for (int pt = 0; pt < 4; ++pt) { accd[pt] = (f32x4){0.f, 0.f, 0.f, 0.f}; acco[pt] = (f32x4){0.f, 0.f, 0.f, 0.f}; }
#pragma unroll
        for (int k2 = 0; k2 < 4; ++k2) {
            if (k2 <= nk2) {
                const int s0 = k2 * 32 + fq * 4, s1 = s0 + 16;
                const f32x4 a0 = *(const LAS f32x4*)(ah + s0), a1 = *(const LAS f32x4*)(ah + s1);
                f32x4 p0, p1;
#pragma unroll
                for (int r = 0; r < 4; ++r) { p0[r] = (s0 + r <= lc) ? cbt[2 * k2][r] * __expf(fminf(al - a0[r], 0.f)) : 0.f; p1[r] = (s1 + r <= lc) ? cbt[2 * k2 + 1][r] * __expf(fminf(al - a1[r], 0.f)) : 0.f; }
                const bf16x8 pf = packf8(p0, p1);
#pragma unroll
                for (int pt = 0; pt < 4; ++pt) { const LAS bf16_t* xp = XT + (pt * 16 + fr) * RS + s0;
                    const bf16x8 xf = cat44(*(const LAS bf16x4*)xp, *(const LAS bf16x4*)(xp + 16)); accd[pt] = mfma16(xf, pf, accd[pt]); }
            }
        }
#pragma unroll
        for (int ks = 0; ks < 4; ++ks) { const bf16x8 cf = *(const LAS bf16x8*)(Cs + l * RS + ks * 32 + fq * 8);
#pragma unroll
            for (int pt = 0; pt < 4; ++pt) { const bf16x8 pvf = *(const LAS bf16x8*)(PV + (pt * 16 + fr) * RS + ks * 32 + fq * 8); acco[pt] = mfma16(pvf, cf, acco[pt]); } }
        const float el = __expf(al), dsk = d_skip[h];
#pragma unroll
        for (int pt = 0; pt < 4; ++pt) { const int p = pt * 16 + fq * 4;
            const u32x2 xv = *(const LAS u32x2*)(XS + l * XR + p); const u32x2 zv = *(const u32x2*)(PA + (row0 + l) * 2816 + h * 64 + p);
            const float xs0 = bflo(xv.x), xs1 = bfhi(xv.x), xs2 = bflo(xv.y), xs3 = bfhi(xv.y);
            float y0 = accd[pt][0] + el * acco[pt][0] + dsk * xs0, y1 = accd[pt][1] + el * acco[pt][1] + dsk * xs1, y2 = accd[pt][2] + el * acco[pt][2] + dsk * xs2, y3 = accd[pt][3] + el * acco[pt][3] + dsk * xs3;
            y0 *= silu(bflo(zv.x)); y1 *= silu(bfhi(zv.x)); y2 *= silu(bflo(zv.y)); y3 *= silu(bfhi(zv.y));
            ssq += (y0 * y0 + y1 * y1) + (y2 * y2 + y3 * y3);
            u32x2 w; w.x = pk2(y0, y1); w.y = pk2(y2, y3); *(u32x2*)(MIX + (row0 + l) * 2048 + h * 64 + p) = w; }
    }
    ssq += __shfl_xor(ssq, 16); ssq += __shfl_xor(ssq, 32);
    const float rstd = 1.0f / sqrtf(ssq * (1.f / 512.f) + EPS);
#pragma unroll 1
    for (int hg = 0; hg < 8; ++hg)
#pragma unroll
        for (int pt = 0; pt < 4; ++pt) { const int ch = (g * 8 + hg) * 64 + pt * 16 + fq * 4; u32x2* q = (u32x2*)(MIX + (row0 + l) * 2048 + ch); const u32x2 v = *q; const f32x4 ng = *(const f32x4*)(norm_g + ch);
            u32x2 w; w.x = pk2(bflo(v.x) * rstd * ng[0], bfhi(v.x) * rstd * ng[1]); w.y = pk2(bflo(v.y) * rstd * ng[2], bfhi(v.y) * rstd * ng[3]); *q = w; }
    __syncthreads();
}

__device__ __forceinline__ void rope_pair8(const bf16_t* src, float pos, const float* inv, float scale, float* o1, float* o2) {
    const u32x4 av = *(const u32x4*)src, cv = *(const u32x4*)(src + 64); float x1[8], x2[8]; unpack8(av, x1); unpack8(cv, x2);
#pragma unroll
    for (int e = 0; e < 8; ++e) { float s, co; sincos_ang(pos * inv[e], s, co); o1[e] = (x1[e] * co - x2[e] * s) * scale; o2[e] = (x2[e] * co + x1[e] * s) * scale; }
}
__device__ __forceinline__ void ret_local_unit(LAS unsigned char* lds, const bf16_t* PB, bf16_t* ST, const float* inv_ret, int b, int c, int h, int tid, int lane, int wave) {
    LAUNDER_V(tid); LAUNDER_V(lane); LAUNDER_S(wave);
    constexpr int RS = 136;
    LAS bf16_t* VT = (LAS bf16_t*)lds;
    LAS bf16_t* KT = (LAS bf16_t*)(lds + 69632);
    const size_t row0 = (size_t)b * SEQ + (size_t)c * 128; const float lg = log2gamma(h);
#pragma unroll 1
    for (int it = 0; it < 2; ++it) { const int idx = tid + it * 512; const int l = idx & 127, ic = idx >> 7; float o1[8], o2[8];
        rope_pair8(PB + (row0 + l) * 3072 + 512 + h * 128 + ic * 8, (float)(c * 128 + l), inv_ret + ic * 8, 0.08838834764831845f * exp2f((float)(127 - l) * lg), o1, o2);
#pragma unroll
        for (int e = 0; e < 8; ++e) { KT[(ic * 8 + e) * RS + l] = (bf16_t)f2bf(o1[e]); KT[(64 + ic * 8 + e) * RS + l] = (bf16_t)f2bf(o2[e]); } }
#pragma unroll 1
    for (int it = 0; it < 8; ++it) { const int idx = tid + it * 512; const int l = idx & 127, vc = idx >> 7;
        const u32x4 a = *(const u32x4*)(PB + (row0 + l) * 3072 + 1024 + h * 256 + vc * 8); LAS bf16_t* dst = VT + (vc * 8) * RS + l;
        dst[0 * RS] = (bf16_t)(a.x & 0xffffu); dst[1 * RS] = (bf16_t)(a.x >> 16); dst[2 * RS] = (bf16_t)(a.y & 0xffffu); dst[3 * RS] = (bf16_t)(a.y >> 16);
        dst[4 * RS] = (bf16_t)(a.z & 0xffffu); dst[5 * RS] = (bf16_t)(a.z >> 16); dst[6 * RS] = (bf16_t)(a.w & 0xffffu); dst[7 * RS] = (bf16_t)(a.w >> 16); }
    __syncthreads();
    const int fr = lane & 15, fq = lane >> 4;
    f32x4 acc[2][8];
#pragma unroll
    for (int vi = 0; vi < 2; ++vi)
#pragma unroll
        for (int dt = 0; dt < 8; ++dt) acc[vi][dt] = (f32x4){0.f, 0.f, 0.f, 0.f};
#pragma unroll
    for (int ks = 0; ks < 4; ++ks) { bf16x8 vf[2];
#pragma unroll
        for (int vi = 0; vi < 2; ++vi) vf[vi] = *(const LAS bf16x8*)(VT + ((2 * wave + vi) * 16 + fr) * RS + ks * 32 + fq * 8);
#pragma unroll
        for (int dt = 0; dt < 8; ++dt) { const bf16x8 kf = *(const LAS bf16x8*)(KT + (dt * 16 + fr) * RS + ks * 32 + fq * 8);
#pragma unroll
            for (int vi = 0; vi < 2; ++vi) acc[vi][dt] = mfma16(kf, vf[vi], acc[vi][dt]); } }
    bf16_t* dst = ST + ((size_t)((b * 128 + c) * 4 + h)) * 32768;
#pragma unroll
    for (int vi = 0; vi < 2; ++vi)
#pragma unroll
        for (int dt = 0; dt < 8; ++dt) { u32x2 w; w.x = pk2(acc[vi][dt][0], acc[vi][dt][1]); w.y = pk2(acc[vi][dt][2], acc[vi][dt][3]); *(u32x2*)(dst + ((2 * wave + vi) * 16 + fr) * 128 + dt * 16 + fq * 4) = w; }
    __syncthreads();
}
__device__ __forceinline__ void ret_out_unit(LAS unsigned char* lds, const bf16_t* PB, const bf16_t* ST, bf16_t* MIX, const float* inv_ret, const float* gn_g, const float* gn_b,
                                             int b, int c, int h, int tid, int lane, int wave) {
    LAUNDER_V(tid); LAUNDER_V(lane); LAUNDER_S(wave);
    constexpr int RS = 136;
    LAS bf16_t* Qs = (LAS bf16_t*)lds;
    LAS bf16_t* Ks = (LAS bf16_t*)(lds + 34816);
    LAS bf16_t* VT = (LAS bf16_t*)(lds + 69632);
    LAS bf16_t* PV = (LAS bf16_t*)(lds + 104448);
    const size_t row0 = (size_t)b * SEQ + (size_t)c * 128; const float lg = log2gamma(h);
    const bf16_t* stsrc = ST + ((size_t)((b * 128 + c) * 4 + h)) * 32768;
#pragma unroll 1
    for (int it = 0; it < 2; ++it) { const int idx = tid + it * 512; const int ic = idx & 7, l = idx >> 3; float o1[8], o2[8]; const float pos = (float)(c * 128 + l);
        rope_pair8(PB + (row0 + l) * 3072 + h * 128 + ic * 8, pos, inv_ret + ic * 8, 1.0f, o1, o2);
        *(LAS u32x4*)(Qs + l * RS + ic * 8) = pack8(o1); *(LAS u32x4*)(Qs + l * RS + 64 + ic * 8) = pack8(o2);
        rope_pair8(PB + (row0 + l) * 3072 + 512 + h * 128 + ic * 8, pos, inv_ret + ic * 8, 0.08838834764831845f, o1, o2);
        *(LAS u32x4*)(Ks + l * RS + ic * 8) = pack8(o1); *(LAS u32x4*)(Ks + l * RS + 64 + ic * 8) = pack8(o2); }
    const int fr = lane & 15, fq = lane >> 4; const int l = wave * 16 + fr; const int wodd = wave | 1, nk2 = wave >> 1;
    f32x4 acc[16];
#pragma unroll
    for (int vt = 0; vt < 16; ++vt) acc[vt] = (f32x4){0.f, 0.f, 0.f, 0.f};
    bf16x8 pf[4], qs[4];
#pragma unroll
    for (int vh = 0; vh < 2; ++vh) {
        if (vh == 1) __syncthreads();
#pragma unroll 1
        for (int it = 0; it < 4; ++it) { const int idx = tid + it * 512; const int s = idx & 127, vc = idx >> 7;
            const u32x4 a = *(const u32x4*)(PB + (row0 + s) * 3072 + 1024 + h * 256 + vh * 128 + vc * 8); LAS bf16_t* dst = VT + (vc * 8) * RS + s;
            dst[0 * RS] = (bf16_t)(a.x & 0xffffu); dst[1 * RS] = (bf16_t)(a.x >> 16); dst[2 * RS] = (bf16_t)(a.y & 0xffffu); dst[3 * RS] = (bf16_t)(a.y >> 16);
            dst[4 * RS] = (bf16_t)(a.z & 0xffffu); dst[5 * RS] = (bf16_t)(a.z >> 16); dst[6 * RS] = (bf16_t)(a.w & 0xffffu); dst[7 * RS] = (bf16_t)(a.w >> 16); }
#pragma unroll 1
        for (int it = 0; it < 4; ++it) { const int idx = tid + it * 512; const int dc = idx & 15, v = idx >> 4; *(LAS u32x4*)(PV + v * RS + dc * 8) = *(const u32x4*)(stsrc + (vh * 128 + v) * 128 + dc * 8); }
        __syncthreads();
        if (vh == 0) {
            f32x4 sc[8];
#pragma unroll
            for (int st = 0; st < 8; ++st) { sc[st] = (f32x4){0.f, 0.f, 0.f, 0.f};
                if (st <= wodd) {
#pragma unroll
                    for (int ks = 0; ks < 4; ++ks) { const bf16x8 kf = *(const LAS bf16x8*)(Ks + (st * 16 + fr) * RS + ks * 32 + fq * 8), qf = *(const LAS bf16x8*)(Qs + l * RS + ks * 32 + fq * 8);
                        sc[st] = mfma16(kf, qf, sc[st]); } } }
#pragma unroll
            for (int k2 = 0; k2 < 4; ++k2) { f32x4 p0, p1; const int s0 = k2 * 32 + fq * 4, s1 = s0 + 16;
#pragma unroll
                for (int r = 0; r < 4; ++r) { p0[r] = (s0 + r <= l) ? sc[2 * k2][r] * exp2f((float)(l - s0 - r) * lg) : 0.f; p1[r] = (s1 + r <= l) ? sc[2 * k2 + 1][r] * exp2f((float)(l - s1 - r) * lg) : 0.f; }
                pf[k2] = packf8(p0, p1); }
            const float fs = exp2f((float)(l + 1) * lg);
#pragma unroll
            for (int ks = 0; ks < 4; ++ks) { const u32x4 qv = *(const LAS u32x4*)(Qs + l * RS + ks * 32 + fq * 8); float x[8]; unpack8(qv, x);
#pragma unroll
                for (int e = 0; e < 8; ++e) x[e] *= fs;
                qs[ks] = __builtin_bit_cast(bf16x8, pack8(x)); }
        }
#pragma unroll
        for (int vt = 0; vt < 8; ++vt) { f32x4 a = acc[vh * 8 + vt];
#pragma unroll
            for (int ks = 0; ks < 4; ++ks) { const bf16x8 pvf = *(const LAS bf16x8*)(PV + (vt * 16 + fr) * RS + ks * 32 + fq * 8); a = mfma16(pvf, qs[ks], a); }
#pragma unroll
            for (int k2 = 0; k2 < 4; ++k2) { if (k2 <= nk2) { const LAS bf16_t* vp = VT + (vt * 16 + fr) * RS + k2 * 32 + fq * 4;
                    const bf16x8 vf = cat44(*(const LAS bf16x4*)vp, *(const LAS bf16x4*)(vp + 16)); a = mfma16(vf, pf[k2], a); } }
            acc[vh * 8 + vt] = a; __builtin_amdgcn_sched_barrier(0); }
    }
    float s = 0.f;
#pragma unroll
    for (int vt = 0; vt < 16; ++vt) s += (acc[vt][0] + acc[vt][1]) + (acc[vt][2] + acc[vt][3]);
    s += __shfl_xor(s, 16); s += __shfl_xor(s, 32);
    const float mean = s * (1.f / 256.f); float qv = 0.f;
#pragma unroll
    for (int vt = 0; vt < 16; ++vt) { acc[vt] = acc[vt] - mean; qv += (acc[vt][0] * acc[vt][0] + acc[vt][1] * acc[vt][1]) + (acc[vt][2] * acc[vt][2] + acc[vt][3] * acc[vt][3]); }
    qv += __shfl_xor(qv, 16); qv += __shfl_xor(qv, 32);
    const float rstd = 1.0f / sqrtf(qv * (1.f / 256.f) + EPS);
#pragma unroll
    for (int vt = 0; vt < 16; ++vt) { const int ch = h * 256 + vt * 16 + fq * 4;
        const u32x2 gv = *(const u32x2*)(PB + (row0 + l) * 3072 + 2048 + ch); const f32x4 gg = *(const f32x4*)(gn_g + ch), gb = *(const f32x4*)(gn_b + ch);
        const f32x4 y = acc[vt] * rstd * gg + gb;
        u32x2 w; w.x = pk2(silu(bflo(gv.x)) * y[0], silu(bfhi(gv.x)) * y[1]); w.y = pk2(silu(bflo(gv.y)) * y[2], silu(bfhi(gv.y)) * y[3]);
        *(u32x2*)(MIX + (row0 + l) * 2048 + 1024 + ch) = w; }
    __syncthreads();
}

#ifdef PROBE_CAT
#define TICK(cat) do { if (blockIdx.x == 0 && threadIdx.x == 0) { volatile LAS unsigned long long* pa = (volatile LAS unsigned long long*)(lds + PTR_OFF + 256); const unsigned long long now = __builtin_amdgcn_s_memrealtime(); pa[cat] += now - pa[15]; pa[15] = now; } } while (0)
#else
#define TICK(cat) do {} while (0)
#endif
#define GSYNC(cat) do { TICK(cat); XcdBarrier xb_; xb_.bar = (unsigned*)ldws(lds); xb_.x = xb_xcc_id(); xb_.st = (volatile LAS unsigned*)(lds + PTR_OFF + 224); xcd_barrier(xb_); TICK(1); } while (0)

__global__ void __launch_bounds__(512, 2) mega_fwd(Params P) {
    extern __shared__ __attribute__((aligned(16))) unsigned char lds_raw[];
    LAS unsigned char* lds = (LAS unsigned char*)lds_raw;
    cg::grid_group grid = cg::this_grid();
    const int tid = threadIdx.x, lane = tid & 63, wave = __builtin_amdgcn_readfirstlane(tid >> 6);
    const int G = gridDim.x, bid = blockIdx.x, gw = bid * 8 + wave, NGW = G * 8, gtid = bid * 512 + tid, nthr = G * 512;
    if (tid == 0) { volatile LAS unsigned long long* t = (volatile LAS unsigned long long*)(lds + PTR_OFF);
#pragma unroll
        for (int i = 0; i < 25; ++i) t[i] = (unsigned long long)P.in[i];
        t[25] = (unsigned long long)P.out; t[26] = (unsigned long long)P.ws; t[27] = 0ull; t[28] = 0ull;
#pragma unroll
        for (int i = 32; i < 48; ++i) t[i] = 0ull;
#ifdef PROBE_CAT
        t[32 + 15] = __builtin_amdgcn_s_memrealtime();
#endif
    }
    if (blockIdx.x == 0) { unsigned* bw = (unsigned*)P.ws; for (int i = tid; i < XCD_BAR_WORDS; i += 512) bw[i] = 0u; }
    __syncthreads();
#define Wb ((bf16_t*)(ldws(lds) + WS_W))
#define XN ((bf16_t*)(ldws(lds) + WS_XN))
#define PROJ ((bf16_t*)(ldws(lds) + WS_PROJ))
#define MIX ((bf16_t*)(ldws(lds) + WS_MIX))
#define ST ((bf16_t*)(ldws(lds) + WS_ST))
#define DEC ((float*)(ldws(lds) + WS_DEC))
#define TAB ((float*)(ldws(lds) + WS_TAB))
#define X (ldout(lds))

    { const float* x = ldin(lds, 0);
        for (size_t i = (size_t)gtid; i < (size_t)M * DM / 8; i += (size_t)nthr) { const f32x4 a = *(const f32x4*)(x + i * 8), c = *(const f32x4*)(x + i * 8 + 4);
            u32x4 w; w.x = pk2(a[0], a[1]); w.y = pk2(a[2], a[3]); w.z = pk2(c[0], c[1]); w.w = pk2(c[2], c[3]); *(u32x4*)(XN + i * 8) = w; }
        if (bid == 0 && tid < 72) {
            float v;
            if (tid < 64) { const float t = (float)tid * (1.0f / 63.0f); v = 1.0f / (float)pow(10000.0, (double)t); }
            else { v = (float)pow(500000.0, -(double)(tid - 64) / 8.0); }
            TAB[tid] = v; }
        convert_layer(0, lds, gw, NGW, lane, wave, gtid, nthr);
    }
    __builtin_amdgcn_fence(__ATOMIC_RELEASE, "agent"); grid.sync(); __builtin_amdgcn_fence(__ATOMIC_ACQUIRE, "agent");
    (void)xcd_barrier_post((unsigned*)ldws(lds), (volatile LAS unsigned*)(lds + PTR_OFF + 224));
    TICK(6);

#pragma unroll 1
    for (int L = 0; L < 4; ++L) {
        const int e = L >> 1; const bool odd = (L & 1) != 0;
#pragma unroll 1
        for (int part = 0; part < 2; ++part) {
            if (part == 0) {
                const int nsub = odd ? 2 : 1;
#pragma unroll 1
                for (int sub = 0; sub < nsub; ++sub) {
                    const int N = odd ? (sub ? 3072 : 2816) : 1792;
                    { pg8::Gemm gm{XN, Wb + WO_IN + (size_t)(sub ? 2816 : 0) * 1024, M, N, 1024}; pg8::StaticOrder S; int bl = bid; LAUNDER_S(bl); S.init(M, N, G, bl);
                        pg8::EpiBf16<0> E{PROJ, N, nullptr, 0, 0, 1.f};
                        pg8::gemm_phase<pg8::EpiBf16<0>, pg8::StaticOrder, true, true>(lds, gm, S, E); }
                    GSYNC(2);
                    if (!odd) {

#ifndef NO_ATTN
for (int u = bid; u < 512; u += G) attn_unit(lds, PROJ, MIX, ldin(lds, 9) + e * 8, TAB + 64, u >> 8, (u >> 1) & 127, u & 1, tid, lane, wave);
#endif


#ifndef NO_CONV
for (int u = bid; u < 1024; u += G) conv_unit(lds, PROJ, MIX, ldin(lds, 10) + (size_t)e * 31 * 512, ldin(lds, 11) + e * 512, ldin(lds, 12) + e * 512, ldin(lds, 13) + e * 512, u >> 9, u & 511, tid, lane, wave);
#endif

                        GSYNC(5);
                    } else if (sub == 0) {
                        const float* cw = ldin(lds, 16) + (size_t)e * 4 * 1536; const float* cb = ldin(lds, 17) + e * 1536; const float* dtb = ldin(lds, 18) + e * 16; const float* alog = ldin(lds, 19) + e * 16;

#ifndef NO_SSDL
for (int u = bid; u < 512; u += G) ssd_local_unit(lds, PROJ, ST, DEC, cw, cb, dtb, alog, u >> 8, (u >> 1) & 127, u & 1, tid, lane, wave);
#endif

                        GSYNC(7);

#ifndef NO_SCAN
scan_phase(ST, DEC, 0, gtid, nthr);
#endif

                        GSYNC(8);

#ifndef NO_SSDO
for (int u = bid; u < 512; u += G) ssd_out_unit(lds, PROJ, ST, MIX, cw, cb, dtb, alog, ldin(lds, 20) + e * 16, ldin(lds, 21) + e * 1024, u >> 8, (u >> 1) & 127, u & 1, tid, lane, wave);
#endif

                        GSYNC(9);
                    } else {

#ifndef NO_RETL
for (int u = bid; u < 1024; u += G) ret_local_unit(lds, PROJ, ST, TAB, u >> 9, (u >> 2) & 127, u & 3, tid, lane, wave);
#endif

                        GSYNC(10);

#ifndef NO_SCAN
scan_phase(ST, DEC, 1, gtid, nthr);
#endif

                        GSYNC(8);

#ifndef NO_RETO
for (int u = bid; u < 1024; u += G) ret_out_unit(lds, PROJ, ST, MIX, TAB, ldin(lds, 22) + e * 1024, ldin(lds, 23) + e * 1024, u >> 9, (u >> 2) & 127, u & 3, tid, lane, wave);
#endif

                        GSYNC(11);
                    }
                }
            } else {
                pg8::Gemm gm{XN, Wb + WO_GU, M, 5632, 1024}; pg8::StaticOrder S; int bl = bid; LAUNDER_S(bl); S.init(M, 5632, G, bl);
                pg8::EpiSwiglu E{PROJ, FFH};
                pg8::gemm_phase<pg8::EpiSwiglu, pg8::StaticOrder, true, true>(lds, gm, S, E);
                GSYNC(3);
            }
            {
                const int K = part ? FFH : (odd ? 2048 : 1024);
                pg8::Gemm gm{part ? PROJ : MIX, Wb + (part ? WO_D : WO_OUT), M, 1024, K}; pg8::StaticOrder S; int bl = bid; LAUNDER_S(bl); S.init(M, 1024, G, bl);
                pg8::EpiRes E{(L == 0 && part == 0) ? ldin(lds, 0) : X, X, 1024, ALPHA};
                pg8::gemm_phase<pg8::EpiRes, pg8::StaticOrder, true, true>(lds, gm, S, E);
            }
            GSYNC(4);

#ifndef NO_LN
ln_phase(X, XN, ldin(lds, part ? 3 : 1) + L * 1024, ldin(lds, part ? 4 : 2) + L * 1024, gw, NGW, lane);
#endif


#ifndef NO_CVT
if (part == 1 && L < 3) convert_layer(L + 1, lds, gw, NGW, lane, wave, gtid, nthr);
#endif

            GSYNC(6);
        }
    }
#ifdef PROBE_CAT
    if (blockIdx.x == 0 && threadIdx.x == 0) { volatile LAS unsigned long long* pa = (volatile LAS unsigned long long*)(lds + PTR_OFF + 256); unsigned long long d = 0; for (int i = 0; i < 15; ++i) if ((PROBE_CAT >> i) & 1) d += pa[i]; const unsigned long long t0 = __builtin_amdgcn_s_memrealtime();
        while (__builtin_amdgcn_s_memrealtime() - t0 < d) __builtin_amdgcn_s_sleep(8); }
#endif
}
}

extern "C" void kernel_launch(void* const* d_in, const int* in_sizes, int n_in, void* d_out, int out_size, void* d_ws, size_t ws_size, hipStream_t stream) {
    static int grid = 0;
    if (grid == 0) {
        int dev = 0, cus = 0, per_cu = 0;
        hipGetDevice(&dev); hipDeviceGetAttribute(&cus, hipDeviceAttributeMultiprocessorCount, dev);
        hipFuncSetAttribute((const void*)mk::mega_fwd, hipFuncAttributeMaxDynamicSharedMemorySize, mk::LDS_BYTES);
        hipOccupancyMaxActiveBlocksPerMultiprocessor(&per_cu, (const void*)mk::mega_fwd, 512, mk::LDS_BYTES);
        if (per_cu < 1) per_cu = 1;
        (void)hipGetLastError();
        grid = cus * 1;
        if (grid <= 0) grid = 256;
    }
    mk::Params p{};
    for (int i = 0; i < 25; ++i) p.in[i] = (const float*)d_in[i];
    p.out = (float*)d_out; p.ws = (unsigned char*)d_ws;
    void* args[] = {&p};
    hipError_t err = hipLaunchCooperativeKernel((const void*)mk::mega_fwd, dim3(grid), dim3(512), args, mk::LDS_BYTES, stream);
    if (err != hipSuccess) fprintf(stderr, "cooperative launch failed: %s (grid %d)\n", hipGetErrorString(err), grid);
}
```
